# Optimizing an MI355X kernel written in HIP

```python
import math
import jax
import jax.numpy as jnp
from jax import lax
import numpy as np

D_MODEL = 2048
BATCH = 16
SEQ = 2048
DEPTH = 2

N_BRANCH = 4
BRANCH_WIDTH = D_MODEL // 4
S5_GROUP = 16
S5_GROUPS = BRANCH_WIDTH // S5_GROUP
S5_STATE = 64
S5_MIN_NEG = 1e-4
HG_HEADS = 4
HG_DIM = BRANCH_WIDTH // HG_HEADS
HG_CHUNK = 64
HG_F_MIN = 1e-6
SB_HEADS = 4
SB_DIM = BRANCH_WIDTH // SB_HEADS
SB_BLOCK = 128
POOL_WINDOWS = (2, 4, 8, 16)
POOL_GROUP = BRANCH_WIDTH // len(POOL_WINDOWS)
IN_SLICES = 9
IN_COLS = IN_SLICES * BRANCH_WIDTH
PEER_HEADS = 8
PEER_NKEYS = 128
PEER_EXPERTS = PEER_NKEYS * PEER_NKEYS
PEER_TOPK = 16
PEER_QDIM = 256
PEER_CHUNK = 128
ADA_CHUNKS = 6
EPS = 1e-6

kernel_name = 'hybrid_s5_hgrn2_stickbreak_pool_peer'


def _rmsnorm(x, gain):
    xf = x.astype(jnp.float32)
    y = xf * lax.rsqrt(jnp.mean(xf * xf, axis=-1, keepdims=True) + EPS)
    return (y * gain.astype(jnp.float32)).astype(x.dtype)


def _modulate(h, shift, scale):
    return h * (1.0 + scale[:, None, :]) + shift[:, None, :]


def _split_heads(t, n_heads, head_dim):
    bsz, seq, _ = t.shape
    return t.astype(jnp.float32).reshape(bsz, seq, n_heads, head_dim).transpose(0, 2, 1, 3)


def _complex_affine_combine(e1, e2):
    a1r, a1i, b1r, b1i = e1
    a2r, a2i, b2r, b2i = e2
    return (a2r * a1r - a2i * a1i,
            a2r * a1i + a2i * a1r,
            a2r * b1r - a2i * b1i + b2r,
            a2r * b1i + a2i * b1r + b2i)


def _s5_mixer(u, lam_re, lam_im, log_step, b_re, b_im, c_re, c_im, d_skip, w_glu, b_glu):
    f32 = jnp.float32
    bsz, seq, _ = u.shape
    uf = u.astype(f32).reshape(bsz, seq, S5_GROUPS, S5_GROUP)
    lr = jnp.minimum(lam_re.astype(f32), -S5_MIN_NEG)
    li = lam_im.astype(f32)
    step = jnp.exp(log_step.astype(f32))[:, None]
    mag = jnp.exp(lr * step)
    ab_re = mag * jnp.cos(li * step)
    ab_im = mag * jnp.sin(li * step)
    den = lr * lr + li * li
    nr = ab_re - 1.0
    fr = (nr * lr + ab_im * li) / den
    fi = (ab_im * lr - nr * li) / den
    br, bi = b_re.astype(f32), b_im.astype(f32)
    bb_re = fr[..., None] * br - fi[..., None] * bi
    bb_im = fr[..., None] * bi + fi[..., None] * br
    bu_re = jnp.einsum('gph,btgh->btgp', bb_re, uf)
    bu_im = jnp.einsum('gph,btgh->btgp', bb_im, uf)
    a_re = jnp.broadcast_to(ab_re, bu_re.shape)
    a_im = jnp.broadcast_to(ab_im, bu_im.shape)
    _, _, xs_re, xs_im = lax.associative_scan(
        _complex_affine_combine, (a_re, a_im, bu_re, bu_im), axis=1)
    y = (jnp.einsum('ghp,btgp->btgh', c_re.astype(f32), xs_re)
         - jnp.einsum('ghp,btgp->btgh', c_im.astype(f32), xs_im)
         + d_skip.astype(f32).reshape(S5_GROUPS, S5_GROUP) * uf)
    y = jax.nn.gelu(y.reshape(bsz, seq, BRANCH_WIDTH), approximate=False)
    out = y * jax.nn.sigmoid(y @ w_glu.astype(f32) + b_glu.astype(f32))
    return out.astype(u.dtype)


def _hgrn2_mixer(q, f, i, g, lower_bound, norm_gain):
    f32 = jnp.float32
    bsz, seq, _ = q.shape
    lb = lower_bound.astype(f32).reshape(HG_HEADS, 1, HG_DIM)
    qh = jax.nn.silu(_split_heads(q, HG_HEADS, HG_DIM))
    vh = _split_heads(i, HG_HEADS, HG_DIM)
    f_gate = lb + (1.0 - lb) * jax.nn.sigmoid(_split_heads(f, HG_HEADS, HG_DIM))
    log_f = jnp.log(jnp.maximum(f_gate, HG_F_MIN))
    kh = 1.0 - f_gate
    n_chunks = seq // HG_CHUNK

    def to_chunks(t):
        return t.reshape(bsz, HG_HEADS, n_chunks, HG_CHUNK, HG_DIM).transpose(2, 0, 1, 3, 4)

    causal = jnp.tril(jnp.ones((HG_CHUNK, HG_CHUNK), dtype=bool))[:, :, None]

    def chunk_step(state, inp):
        qc, kc, vc, gc = inp
        bcum = jnp.cumsum(gc, axis=2)
        o_inter = jnp.einsum('bhtd,bhde->bhte', qc * jnp.exp(bcum), state)
        diff = bcum[:, :, :, None, :] - bcum[:, :, None, :, :]
        decay = jnp.where(causal, jnp.exp(jnp.where(causal, diff, 0.0)), 0.0)
        scores = jnp.einsum('bhtd,bhsd,bhtsd->bhts', qc, kc, decay)
        o_intra = jnp.einsum('bhts,bhse->bhte', scores, vc)
        b_last = bcum[:, :, -1:, :]
        k_dec = kc * jnp.exp(b_last - bcum)
        new_state = (jnp.exp(b_last[:, :, 0, :, None]) * state
                     + jnp.einsum('bhsd,bhse->bhde', k_dec, vc))
        return new_state, o_inter + o_intra

    state0 = jnp.zeros((bsz, HG_HEADS, HG_DIM, HG_DIM), f32)
    _, o = lax.scan(chunk_step, state0,
                    (to_chunks(qh), to_chunks(kh), to_chunks(vh), to_chunks(log_f)))
    o = o.transpose(1, 0, 3, 2, 4).reshape(bsz, seq, HG_HEADS, HG_DIM)
    o = (o * lax.rsqrt(jnp.mean(o * o, axis=-1, keepdims=True) + EPS)
         * norm_gain.astype(f32).reshape(HG_HEADS, HG_DIM))
    o = o.reshape(bsz, seq, BRANCH_WIDTH) * jax.nn.silu(g.astype(f32))
    return o.astype(q.dtype)


def _stick_breaking_mixer(q, k, v):
    bsz, seq, _ = q.shape
    qh = _split_heads(q, SB_HEADS, SB_DIM)
    kh = _split_heads(k, SB_HEADS, SB_DIM)
    vh = _split_heads(v, SB_HEADS, SB_DIM)
    scale = 1.0 / math.sqrt(SB_DIM)
    outs = []
    for blk in range(seq // SB_BLOCK):
        start = blk * SB_BLOCK
        end = start + SB_BLOCK
        z = jnp.einsum('bhtd,bhsd->bhts', qh[:, :, start:end], kh[:, :, :end]) * scale
        t_idx = start + jnp.arange(SB_BLOCK)[:, None]
        s_idx = jnp.arange(end)[None, :]
        mask = s_idx < t_idx
        log_not = jnp.where(mask, jax.nn.log_sigmoid(-z), 0.0)
        suffix = jnp.flip(jnp.cumsum(jnp.flip(log_not, -1), axis=-1), -1) - log_not
        weight = jnp.where(mask, jnp.exp(jax.nn.log_sigmoid(z) + suffix), 0.0)
        outs.append(jnp.einsum('bhts,bhse->bhte', weight, vh[:, :, :end]))
    o = jnp.concatenate(outs, axis=2)
    return o.transpose(0, 2, 1, 3).reshape(bsz, seq, BRANCH_WIDTH).astype(q.dtype)


def _pool_mixer(p, pool_w, pool_scale):
    f32 = jnp.float32
    bsz, seq, _ = p.shape
    pf = p.astype(f32).reshape(bsz, seq, len(POOL_WINDOWS), POOL_GROUP)
    csum = jnp.cumsum(pf, axis=1)
    pooled = []
    for gi, w in enumerate(POOL_WINDOWS):
        cs = csum[:, :, gi]
        lagged = jnp.pad(cs, ((0, 0), (w, 0), (0, 0)))[:, :seq]
        count = jnp.minimum(jnp.arange(1, seq + 1), w).astype(f32)[None, :, None]
        pooled.append((cs - lagged) / count - pf[:, :, gi])
    pooled = jnp.stack(pooled, axis=2)
    mixed = jnp.einsum('btgc,gcd->btgd', pooled, pool_w.astype(f32))
    return (mixed.reshape(bsz, seq, BRANCH_WIDTH) * pool_scale.astype(f32)).astype(p.dtype)


def _hybrid_mixer(h, w_in, s5_lambda_re, s5_lambda_im, s5_log_step, s5_b_re, s5_b_im,
                  s5_c_re, s5_c_im, s5_d, s5_w_glu, s5_b_glu, hg_lower_bound, hg_norm_gain,
                  pool_w, pool_scale, w_gate, w_branch, w_out):
    proj = h @ w_in
    s5_u, hg_q, hg_f, hg_i, hg_g, sb_q, sb_k, sb_v, pool_in = jnp.split(proj, IN_SLICES, axis=-1)
    branches = (
        _s5_mixer(s5_u, s5_lambda_re, s5_lambda_im, s5_log_step, s5_b_re, s5_b_im,
                  s5_c_re, s5_c_im, s5_d, s5_w_glu, s5_b_glu),
        _hgrn2_mixer(hg_q, hg_f, hg_i, hg_g, hg_lower_bound, hg_norm_gain),
        _stick_breaking_mixer(sb_q, sb_k, sb_v),
        _pool_mixer(pool_in, pool_w, pool_scale),
    )
    terms = [jax.nn.sigmoid(h @ w_gate[n]) * (yb @ w_branch[n]) for n, yb in enumerate(branches)]
    merged = terms[0] + terms[1] + terms[2] + terms[3]
    return merged @ w_out


def _peer(h, w_query, sub_keys, expert_u, expert_v):
    f32 = jnp.float32
    bsz, seq, d = h.shape
    tokens = h.reshape(-1, PEER_CHUNK, d)
    keys = sub_keys.astype(f32)

    def per_block(xc):
        q = (xc @ w_query).astype(f32).reshape(PEER_CHUNK, PEER_HEADS, 2, PEER_QDIM // 2)
        scores = jnp.einsum('thpd,hpkd->thpk', q, keys)
        top_val, top_idx = lax.top_k(scores, PEER_TOPK)
        cand = top_val[:, :, 0, :, None] + top_val[:, :, 1, None, :]
        cand_idx = top_idx[:, :, 0, :, None] * PEER_NKEYS + top_idx[:, :, 1, None, :]
        cand = cand.reshape(PEER_CHUNK, PEER_HEADS, PEER_TOPK * PEER_TOPK)
        cand_idx = cand_idx.reshape(PEER_CHUNK, PEER_HEADS, PEER_TOPK * PEER_TOPK)
        best_val, best_pos = lax.top_k(cand, PEER_TOPK)
        expert_idx = jnp.take_along_axis(cand_idx, best_pos, axis=-1)
        gate = jax.nn.softmax(best_val, axis=-1)
        u = jnp.take(expert_u, expert_idx, axis=0)
        v = jnp.take(expert_v, expert_idx, axis=0)
        act = jax.nn.gelu(jnp.einsum('td,thkd->thk', xc, u), approximate=False)
        return jnp.einsum('thk,thkd->td', (gate * act).astype(v.dtype), v)

    out = lax.map(per_block, tokens)
    return out.reshape(bsz, seq, d).astype(h.dtype)


def setup_inputs(seed: int = 0) -> dict:
    key = jax.random.key(seed)
    ks = jax.random.split(key, 32)
    f32 = jnp.float32

    def nrm(k, shape, scale):
        return jax.random.normal(k, shape, f32) * scale

    L, G, P, H = DEPTH, S5_GROUPS, S5_STATE, S5_GROUP
    return {
        'x': nrm(ks[0], (BATCH, SEQ, D_MODEL), 1.0),
        'c': nrm(ks[1], (BATCH, D_MODEL), 1.0),
        'ada_w': nrm(ks[2], (L, D_MODEL, ADA_CHUNKS * D_MODEL), 0.5 * D_MODEL ** -0.5),
        'ada_b': nrm(ks[3], (L, ADA_CHUNKS * D_MODEL), 0.02),
        'norm_mix_gain': 1.0 + nrm(ks[4], (L, D_MODEL), 0.02),
        'norm_ffn_gain': 1.0 + nrm(ks[5], (L, D_MODEL), 0.02),
        'w_in': nrm(ks[6], (L, D_MODEL, IN_COLS), D_MODEL ** -0.5),
        's5_lambda_re': -0.5 + nrm(ks[7], (L, G, P), 0.01),
        's5_lambda_im': math.pi * jnp.arange(P, dtype=f32) + nrm(ks[8], (L, G, P), 0.01),
        's5_log_step': jax.random.uniform(ks[9], (L, G), f32, math.log(1e-3), math.log(1e-1)),
        's5_b_re': nrm(ks[10], (L, G, P, H), (2.0 * H) ** -0.5),
        's5_b_im': nrm(ks[11], (L, G, P, H), (2.0 * H) ** -0.5),
        's5_c_re': nrm(ks[12], (L, G, H, P), P ** -0.5),
        's5_c_im': nrm(ks[13], (L, G, H, P), P ** -0.5),
        's5_d': nrm(ks[14], (L, BRANCH_WIDTH), 1.0),
        's5_w_glu': nrm(ks[15], (L, BRANCH_WIDTH, BRANCH_WIDTH), BRANCH_WIDTH ** -0.5),
        's5_b_glu': nrm(ks[16], (L, BRANCH_WIDTH), 0.02),
        'hg_lb_logits': 1.0 + nrm(ks[17], (L, BRANCH_WIDTH), 0.1),
        'hg_norm_gain': 1.0 + nrm(ks[18], (L, BRANCH_WIDTH), 0.02),
        'pool_w': nrm(ks[19], (L, len(POOL_WINDOWS), POOL_GROUP, POOL_GROUP), POOL_GROUP ** -0.5),
        'pool_scale': 1.0 + nrm(ks[20], (L, BRANCH_WIDTH), 0.02),
        'w_gate': nrm(ks[21], (L, N_BRANCH, D_MODEL, D_MODEL), D_MODEL ** -0.5),
        'w_branch': nrm(ks[22], (L, N_BRANCH, BRANCH_WIDTH, D_MODEL), BRANCH_WIDTH ** -0.5),
        'w_out': nrm(ks[23], (L, D_MODEL, D_MODEL), D_MODEL ** -0.5),
        'peer_w_query': nrm(ks[24], (L, D_MODEL, PEER_HEADS * PEER_QDIM), D_MODEL ** -0.5),
        'peer_sub_keys': nrm(ks[25], (L, PEER_HEADS, 2, PEER_NKEYS, PEER_QDIM // 2), (PEER_QDIM // 2) ** -0.5),
        'peer_u': nrm(ks[26], (L, PEER_EXPERTS, D_MODEL), D_MODEL ** -0.5),
        'peer_v': nrm(ks[27], (L, PEER_EXPERTS, D_MODEL), 0.5),
        'final_gain': 1.0 + nrm(ks[28], (D_MODEL,), 0.02),
    }


def reference(x, c, ada_w, ada_b, norm_mix_gain, norm_ffn_gain, w_in,
              s5_lambda_re, s5_lambda_im, s5_log_step, s5_b_re, s5_b_im, s5_c_re, s5_c_im,
              s5_d, s5_w_glu, s5_b_glu, hg_lb_logits, hg_norm_gain, pool_w, pool_scale,
              w_gate, w_branch, w_out, peer_w_query, peer_sub_keys, peer_u, peer_v, final_gain):
    lb_soft = jax.nn.softmax(hg_lb_logits.astype(jnp.float32), axis=0)
    lower_bounds = jnp.cumsum(lb_soft, axis=0) - lb_soft[0:1]
    cond = jax.nn.silu(c)
    for l in range(DEPTH):
        mod = cond @ ada_w[l] + ada_b[l]
        sh1, sc1, g1, sh2, sc2, g2 = jnp.split(mod, ADA_CHUNKS, axis=-1)
        h = _modulate(_rmsnorm(x, norm_mix_gain[l]), sh1, sc1)
        y = _hybrid_mixer(h, w_in[l], s5_lambda_re[l], s5_lambda_im[l], s5_log_step[l],
                          s5_b_re[l], s5_b_im[l], s5_c_re[l], s5_c_im[l], s5_d[l],
                          s5_w_glu[l], s5_b_glu[l], lower_bounds[l], hg_norm_gain[l],
                          pool_w[l], pool_scale[l], w_gate[l], w_branch[l], w_out[l])
        x = x + g1[:, None, :] * y
        h = _modulate(_rmsnorm(x, norm_ffn_gain[l]), sh2, sc2)
        x = x + g2[:, None, :] * _peer(h, peer_w_query[l], peer_sub_keys[l], peer_u[l], peer_v[l])
    return _rmsnorm(x, final_gain)
```

```cpp
#include <hip/hip_runtime.h>
#include <cstdio>
#include <cstdint>

#ifndef N_LAUNCHES
#define N_LAUNCHES 1
#endif

#define LAS __attribute__((address_space(3)))
typedef unsigned short bf16_t;
typedef short bf16x8 __attribute__((ext_vector_type(8)));
typedef float f32x4 __attribute__((ext_vector_type(4)));
typedef float f32x2 __attribute__((ext_vector_type(2)));
typedef unsigned u32x4 __attribute__((ext_vector_type(4)));
typedef unsigned u32x2 __attribute__((ext_vector_type(2)));

constexpr int D = 2048, BATCH = 16, SEQ = 2048, M = BATCH * SEQ, DEPTH = 2;
constexpr int BW = 512, INC = 4608, NCAT = INC + 4 * D  , ADA = 6 * D;
constexpr int NEXP = 16384;
constexpr float EPS = 1e-6f;

__device__ __forceinline__ float bf2f(unsigned v) { return __uint_as_float(v << 16); }
__device__ __forceinline__ float bflo(unsigned w) { return __uint_as_float(w << 16); }
__device__ __forceinline__ float bfhi(unsigned w) { return __uint_as_float(w & 0xffff0000u); }
typedef __bf16 bf16x2_t __attribute__((ext_vector_type(2)));
__device__ __forceinline__ unsigned cvt_pk_bf16(float lo, float hi) { const bf16x2_t v = __builtin_convertvector((f32x2){lo, hi}, bf16x2_t); return __builtin_bit_cast(unsigned, v); }
__device__ __forceinline__ bf16_t f2bf(float f) { return (bf16_t)(cvt_pk_bf16(f, 0.f) & 0xffffu); }
__device__ __forceinline__ float sigmoidf_(float x) { return __builtin_amdgcn_rcpf(1.0f + __expf(-x)); }
__device__ __forceinline__ float siluf_(float x) { return x * __builtin_amdgcn_rcpf(1.0f + __expf(-x)); }
__device__ __forceinline__ float gelu_erf(float x) {
    const float z = fabsf(x) * 0.70710678118654752f, t = __builtin_amdgcn_rcpf(__builtin_fmaf(0.3275911f, z, 1.0f));
    const float poly = t * __builtin_fmaf(t, __builtin_fmaf(t, __builtin_fmaf(t, __builtin_fmaf(t, 1.061405429f, -1.453152027f), 1.421413741f), -0.284496736f), 0.254829592f);
    const float er = __builtin_fmaf(-poly, __expf(-z * z), 1.0f);
    return 0.5f * x * (1.0f + __builtin_copysignf(er, x));
}

#define WAVE_SYNC() asm volatile("s_waitcnt lgkmcnt(0)" ::: "memory")

#ifndef PG8_USE_SP2
#define PG8_USE_SP2 true
#endif
namespace pg8 {
constexpr int BM = 256, BK = 64, HALF = 128, HTB = HALF * BK * 2, STAGE_BYTES = 8 * HTB, NXCD = 8, WGM = 8;
__host__ __device__ __forceinline__ int lds_byte(int r, int c) { const int st = (r >> 4) * 2 + (c >> 5), rr = r & 15, cc = c & 31, ob = rr * 64 + cc * 2; return st * 1024 + (ob ^ (((ob >> 9) & 1) << 5)); }
__host__ __device__ __forceinline__ void stage_rc(int b, int& R, int& C) { const int st = b / 1024, sb = b % 1024, swz = sb ^ (((sb >> 9) & 1) << 5); R = (st >> 1) * 16 + swz / 64; C = (st & 1) * 32 + (swz % 64) / 2; }
__host__ __device__ __forceinline__ int perm32(int rho) { const int n = rho >> 4, i = rho & 15; return 8 * (i >> 2) + 4 * n + (i & 3); }
struct Unit { int pm, pn, pz; };
struct Gemm { const bf16_t* A; const bf16_t* Bt; int M, N, K, lda, ldb, apn; size_t zA, zB; };
struct StaticOrder {
    int nM, nN, nwg, G, c;
    __host__ __device__ void init(int M_, int N_, int G_, int c_) { nM = M_ / BM; nN = N_ / BM; nwg = nM * nN; G = G_; c = c_; }
    __host__ __device__ bool next(int i, Unit& u) const { return decode((long)i * G + c, u); }
    __host__ __device__ bool decode(long L, Unit& u) const {
        if (L >= nwg) return false;
        int wgid = (int)L; { const int q = nwg / NXCD, r = nwg % NXCD, xcd = wgid % NXCD, off = wgid / NXCD; wgid = (xcd < r ? xcd * (q + 1) : r * (q + 1) + (xcd - r) * q) + off; }
        const int nig = WGM * nN, gid = wgid / nig, fm = gid * WGM, gsz = (nM - fm) < WGM ? (nM - fm) : WGM;
        u.pm = fm + ((wgid % nig) % gsz); u.pn = (wgid % nig) / gsz; u.pz = 0; return true;
    }
    __device__ __forceinline__ void a_ready(const Unit&) const {}
    __device__ __forceinline__ void done(const Unit&) const {}
};
struct LateOrder : StaticOrder {
    int nhg, r0, ex;
    __host__ __device__ bool next(int i, Unit& u) const {
        if (i < r0) return decode((long)i * G + c, u);
        if (c < nhg || i >= r0 + ex) return false;
        return decode((long)r0 * G + (long)(c - nhg) * ex + (i - r0), u);
    }
};
template <int NZ> struct ZInnerOrder : StaticOrder {
    __host__ __device__ bool next(int i, Unit& u) const { const bool ok = StaticOrder::next(i / NZ, u); u.pz = i % NZ; return ok; }
};
template <class Epi, class Sched, bool SP2 = PG8_USE_SP2>
__device__ __forceinline__ void gemm_phase(LAS unsigned char* lds, const Gemm g, const Sched& S, const Epi& E) {
    int tid_ = threadIdx.x; asm volatile("" : "+v"(tid_));
    const int tid = tid_, wid = __builtin_amdgcn_readfirstlane(tid >> 6), lane = tid & 63, wr = wid >> 2, wc = wid & 3, fr = lane & 15, fq = lane >> 4;
    const int K = g.K, nt = K / BK;
    unsigned voffA[2], voffB[2];
#pragma unroll
    for (int i = 0; i < 2; ++i) { int R, C; stage_rc(tid * 16 + i * 8192, R, C); const int Rb = Epi::PERM ? ((R & ~31) + perm32(R & 31)) : R;
        voffA[i] = (unsigned)(R * g.lda + C) * 2u; voffB[i] = (unsigned)(Rb * g.ldb + C) * 2u; }
    const size_t kstep = (size_t)(BK * 2);
    const size_t hstepA = (size_t)HALF * g.lda * 2, hstepB = (size_t)HALF * g.ldb * 2;
    const size_t tstepA = 2 * hstepA, tstepB = 2 * hstepB, pstepA = (size_t)g.apn * 2, zstepA = g.zA * 2, zstepB = g.zB * 2;
    const unsigned ldsw = (unsigned)wid * 1024u;
    const int aoff = lds_byte(wr * 64 + fr, fq * 8), boff = lds_byte(wc * 32 + fr, fq * 8);
#define PG8_SA(b, h) (((b) * 2 + (h)) * HTB)
#define PG8_SB(b, h) ((4 + (b) * 2 + (h)) * HTB)
#define PG8_STAGE(bufoff, gbase, voff) do { _Pragma("unroll") for (int _i = 0; _i < 2; ++_i) \
        __builtin_amdgcn_global_load_lds((const unsigned*)((const char*)(gbase) + (voff)[_i]), (LAS unsigned*)(lds + (bufoff) + ldsw + _i * 8192), 16, 0, 0); } while (0)
#define PG8_LDA(dst, b, h) do { _Pragma("unroll") for (int m = 0; m < 4; ++m) _Pragma("unroll") for (int k = 0; k < 2; ++k) dst[m][k] = *(const LAS bf16x8*)(lds + PG8_SA(b, h) + aoff + m * 2048 + k * 1024); } while (0)
#define PG8_LDB(dst, b, h) do { _Pragma("unroll") for (int n = 0; n < 2; ++n) _Pragma("unroll") for (int k = 0; k < 2; ++k) dst[n][k] = *(const LAS bf16x8*)(lds + PG8_SB(b, h) + boff + n * 2048 + k * 1024); } while (0)
#define PG8_MMA(ai, bj, At, Bt) do { __builtin_amdgcn_s_setprio(1); _Pragma("unroll") for (int m = 0; m < 4; ++m) _Pragma("unroll") for (int n = 0; n < 2; ++n) _Pragma("unroll") for (int k = 0; k < 2; ++k) \
        acc[ai][bj][m][n] = __builtin_amdgcn_mfma_f32_16x16x32_bf16(Bt[n][k], At[m][k], acc[ai][bj][m][n], 0, 0, 0); __builtin_amdgcn_s_setprio(0); } while (0)
#define PG8_WAIT_V(n) asm volatile("s_waitcnt vmcnt(" #n ")" ::: "memory")
#define PG8_WAIT_L(n) asm volatile("s_waitcnt lgkmcnt(" #n ")" ::: "memory")
#define PG8_BAR __builtin_amdgcn_s_barrier()
#define PG8_SCHED __builtin_amdgcn_sched_barrier(0)
    Unit cur, nxt; int ui = 0;
    if (!S.next(0, cur)) return;
    f32x4 acc[2][2][4][2];
#pragma unroll
    for (int a = 0; a < 2; ++a)
#pragma unroll
        for (int b = 0; b < 2; ++b)
#pragma unroll
            for (int m = 0; m < 4; ++m)
#pragma unroll
                for (int n = 0; n < 2; ++n) acc[a][b][m][n] = (f32x4){0.f, 0.f, 0.f, 0.f};
    bf16x8 At[4][2], B0[2][2], B1[2][2];
    const char* cA = (const char*)g.A + (size_t)cur.pm * tstepA + (size_t)cur.pn * pstepA + (size_t)cur.pz * zstepA; const char* cB = (const char*)g.Bt + (size_t)cur.pn * tstepB + (size_t)cur.pz * zstepB;
    S.a_ready(cur);
    if constexpr (SP2) {
        PG8_STAGE(PG8_SB(0, 0), cB, voffB); PG8_STAGE(PG8_SB(0, 1), cB + hstepB, voffB); PG8_STAGE(PG8_SA(0, 0), cA, voffA); PG8_STAGE(PG8_SA(0, 1), cA + hstepA, voffA);
        if (wr == 1) PG8_BAR;
        PG8_WAIT_V(2); PG8_BAR;
        PG8_STAGE(PG8_SB(1, 0), cB + kstep, voffB); PG8_STAGE(PG8_SA(1, 0), cA + kstep, voffA); PG8_STAGE(PG8_SB(1, 1), cB + hstepB + kstep, voffB);
        PG8_WAIT_V(6); PG8_BAR;
    } else {
    PG8_STAGE(PG8_SB(0, 0), cB, voffB); PG8_STAGE(PG8_SA(0, 0), cA, voffA); PG8_STAGE(PG8_SB(0, 1), cB + hstepB, voffB); PG8_STAGE(PG8_SA(0, 1), cA + hstepA, voffA);
    if (wr == 1) PG8_BAR;
    PG8_WAIT_V(4); PG8_BAR;
    PG8_STAGE(PG8_SB(1, 0), cB + kstep, voffB); PG8_STAGE(PG8_SA(1, 0), cA + kstep, voffA); PG8_STAGE(PG8_SB(1, 1), cB + hstepB + kstep, voffB);
    PG8_WAIT_V(6); PG8_BAR;
    }
    for (;;) {
        const bool has_next = S.next(ui + 1, nxt);
        const char* nA = has_next ? (const char*)g.A + (size_t)nxt.pm * tstepA + (size_t)nxt.pn * pstepA + (size_t)nxt.pz * zstepA : cA; const char* nB = has_next ? (const char*)g.Bt + (size_t)nxt.pn * tstepB + (size_t)nxt.pz * zstepB : cB;
        for (int t = 0; t < nt; t += 2) {
            const bool last = (t == nt - 2);
            const char* a1 = cA + (size_t)(t + 1) * kstep;
            const char* a2 = last ? nA : cA + (size_t)(t + 2) * kstep; const char* b2 = last ? nB : cB + (size_t)(t + 2) * kstep;
            const char* a3 = a2 + kstep; const char* b3 = b2 + kstep;
            if (last && has_next) S.a_ready(nxt);
            if constexpr (Epi::KHOOK) { if (t != 0 && (t & 7) == 0) E.khook(acc, cur, t >> 3, wr, wc, fr, fq); }
            if constexpr (SP2) {
            PG8_LDB(B0, 0, 0); PG8_LDB(B1, 0, 1); PG8_SCHED; PG8_LDA(At, 0, 0); PG8_STAGE(PG8_SA(1, 1), a1 + hstepA, voffA);
            PG8_WAIT_V(8); PG8_WAIT_L(0); PG8_BAR; PG8_MMA(0, 0, At, B0); PG8_MMA(0, 1, At, B1); PG8_BAR; PG8_SCHED;
            PG8_LDA(At, 0, 1); PG8_STAGE(PG8_SB(0, 0), b2, voffB); PG8_STAGE(PG8_SB(0, 1), b2 + hstepB, voffB); PG8_STAGE(PG8_SA(0, 0), a2, voffA);
            PG8_WAIT_V(8); PG8_WAIT_L(0); PG8_BAR; PG8_MMA(1, 0, At, B0); PG8_MMA(1, 1, At, B1); PG8_BAR; PG8_SCHED;
            PG8_LDB(B0, 1, 0); PG8_LDB(B1, 1, 1); PG8_SCHED; PG8_LDA(At, 1, 0); PG8_STAGE(PG8_SA(0, 1), a2 + hstepA, voffA);
            PG8_WAIT_V(8); PG8_WAIT_L(0); PG8_BAR; PG8_MMA(0, 0, At, B0); PG8_MMA(0, 1, At, B1); PG8_BAR; PG8_SCHED;
            PG8_LDA(At, 1, 1); PG8_STAGE(PG8_SB(1, 0), b3, voffB); PG8_STAGE(PG8_SB(1, 1), b3 + hstepB, voffB); PG8_STAGE(PG8_SA(1, 0), a3, voffA);
            PG8_WAIT_V(8); PG8_WAIT_L(0); PG8_BAR; PG8_MMA(1, 0, At, B0); PG8_MMA(1, 1, At, B1); PG8_BAR; PG8_SCHED;
            } else {
            PG8_LDB(B0, 0, 0); PG8_SCHED; PG8_LDA(At, 0, 0); PG8_STAGE(PG8_SA(1, 1), a1 + hstepA, voffA);
            PG8_WAIT_L(8); PG8_BAR; PG8_WAIT_L(0); PG8_MMA(0, 0, At, B0); PG8_BAR; PG8_SCHED;
            PG8_LDB(B1, 0, 1); PG8_STAGE(PG8_SB(0, 0), b2, voffB);
            PG8_BAR; PG8_WAIT_L(0); PG8_MMA(0, 1, At, B1); PG8_BAR;
            PG8_LDA(At, 0, 1); PG8_STAGE(PG8_SA(0, 0), a2, voffA);
            PG8_BAR; PG8_WAIT_L(0); PG8_MMA(1, 0, At, B0); PG8_BAR; PG8_SCHED;
            PG8_STAGE(PG8_SB(0, 1), b2 + hstepB, voffB);
            PG8_WAIT_V(6); PG8_BAR; PG8_MMA(1, 1, At, B1); PG8_BAR;
            PG8_LDB(B0, 1, 0); PG8_SCHED; PG8_LDA(At, 1, 0); PG8_STAGE(PG8_SA(0, 1), a2 + hstepA, voffA);
            PG8_WAIT_L(8); PG8_BAR; PG8_WAIT_L(0); PG8_MMA(0, 0, At, B0); PG8_BAR; PG8_SCHED;
            PG8_LDB(B1, 1, 1); PG8_STAGE(PG8_SB(1, 0), b3, voffB);
            PG8_BAR; PG8_WAIT_L(0); PG8_MMA(0, 1, At, B1); PG8_BAR;
            PG8_LDA(At, 1, 1); PG8_STAGE(PG8_SA(1, 0), a3, voffA);
            PG8_BAR; PG8_WAIT_L(0); PG8_MMA(1, 0, At, B0); PG8_BAR; PG8_SCHED;
            PG8_STAGE(PG8_SB(1, 1), b3 + hstepB, voffB);
            PG8_WAIT_V(6); PG8_BAR; PG8_MMA(1, 1, At, B1); PG8_BAR;
            }
        }
        E(acc, cur, wr, wc, fr, fq); S.done(cur);
        if (!has_next) break;
#pragma unroll
        for (int a = 0; a < 2; ++a)
#pragma unroll
            for (int b = 0; b < 2; ++b)
#pragma unroll
                for (int m = 0; m < 4; ++m)
#pragma unroll
                    for (int n = 0; n < 2; ++n) acc[a][b][m][n] = (f32x4){0.f, 0.f, 0.f, 0.f};
        cur = nxt; cA = nA; cB = nB; ++ui;
    }
    PG8_WAIT_V(0);
    if (wr == 0) PG8_BAR;
    PG8_BAR;
#undef PG8_SA
#undef PG8_SB
#undef PG8_STAGE
#undef PG8_LDA
#undef PG8_LDB
#undef PG8_MMA
#undef PG8_WAIT_V
#undef PG8_WAIT_L
#undef PG8_BAR
#undef PG8_SCHED
}
}

#define XB_TMO      128
#define XB_XCNT(j)  (256  + 64 * (j))
#define XB_XSUB(j)  (1280 + 64 * (j))
#define XB_XGEN(j)  (2304 + 64 * (j))
#define XB_TOP      3328
#define XB_TOPGEN   3392
#define XCD_BAR_WORDS 3456
#define XB_SPIN_CAP (1u << 20)
__device__ __forceinline__ unsigned xb_ld(unsigned* p)              { return __hip_atomic_load(p, __ATOMIC_RELAXED, __HIP_MEMORY_SCOPE_AGENT); }
__device__ __forceinline__ unsigned xb_add(unsigned* p, unsigned v) { return __hip_atomic_fetch_add(p, v, __ATOMIC_RELAXED, __HIP_MEMORY_SCOPE_AGENT); }
__device__ __forceinline__ unsigned xb_xcc_id() { return (unsigned)__builtin_amdgcn_s_getreg((3 << 11) | 20) & 0xFu; }
#define XB_SPIN(cond, bar) do { unsigned _sp = 0; while (cond) { __builtin_amdgcn_s_sleep(1); \
    if ((++_sp & 255u) == 0u) { if (xb_ld(&(bar)[XB_TMO])) break; if (_sp > XB_SPIN_CAP) { atomicAdd(&(bar)[XB_TMO], 1u); break; } } } } while (0)
struct XcdBarrier { unsigned* bar; unsigned x; volatile LAS unsigned* st; };
__device__ __forceinline__ XcdBarrier xcd_barrier_post(unsigned* bar, volatile LAS unsigned* st) {
    XcdBarrier b; b.bar = bar; b.x = xb_xcc_id(); b.st = st;
    if (threadIdx.x == 0) (void)xb_add(&bar[XB_XCNT(b.x)], 1u);
    return b;
}
__device__ __forceinline__ void xcd_barrier_complete(unsigned* bar, unsigned x, unsigned& nloc, unsigned& nx) {
    const unsigned G = gridDim.x * gridDim.y * gridDim.z;
    unsigned sum, cnt, mine, sp = 0u;
    for (;;) {
        sum = 0u; cnt = 0u; mine = 0u;
#pragma unroll
        for (unsigned j = 0; j < 16; ++j) { const unsigned c = xb_ld(&bar[XB_XCNT(j)]); sum += c; cnt += (c > 0u) ? 1u : 0u; mine = (j == x) ? c : mine; }
        if (sum == G) break;
        __builtin_amdgcn_s_sleep(1);
        if ((++sp & 255u) == 0u) { if (xb_ld(&bar[XB_TMO])) break; if (sp > XB_SPIN_CAP) { atomicAdd(&bar[XB_TMO], 1u); break; } }
    }
    nloc = mine > 0u ? mine : 1u; nx = cnt > 0u ? cnt : 1u;
}
__device__ __forceinline__ void xcd_barrier(const XcdBarrier& b) {
    asm volatile("s_waitcnt vmcnt(0)" ::: "memory");
    __syncthreads();
    if (threadIdx.x == 0) {
        unsigned* bar = b.bar;
        __builtin_amdgcn_s_waitcnt(0);
        unsigned nloc = b.st[0], nx = b.st[1];
        if (nloc == 0u) { xcd_barrier_complete(bar, b.x, nloc, nx); b.st[0] = nloc; b.st[1] = nx; }
        const unsigned old = xb_add(&bar[XB_XSUB(b.x)], 1u);
        const unsigned gen = old / nloc;
        if (old + 1u == (gen + 1u) * nloc) {
            __builtin_amdgcn_fence(__ATOMIC_RELEASE, "agent");
            asm volatile("s_waitcnt vmcnt(0)" ::: "memory");
            const unsigned og = xb_add(&bar[XB_TOP], 1u);
            const unsigned tg = og / nx;
            if (og + 1u == (tg + 1u) * nx) xb_add(&bar[XB_TOPGEN], 1u);
            else XB_SPIN(xb_ld(&bar[XB_TOPGEN]) == tg, bar);
            __builtin_amdgcn_fence(__ATOMIC_ACQUIRE, "agent");
            xb_add(&bar[XB_XGEN(b.x)], 1u);
            asm volatile("s_waitcnt vmcnt(0)" ::: "memory");
        } else {
            XB_SPIN(xb_ld(&bar[XB_XGEN(b.x)]) == gen, bar);
            __builtin_amdgcn_fence(__ATOMIC_ACQUIRE, "agent");
            asm volatile("s_waitcnt vmcnt(0)" ::: "memory");
        }
    }
    __syncthreads();
}

constexpr size_t al256(size_t x) { return (x + 255) & ~(size_t)255; }
constexpr size_t WS_CTL   = 0;
constexpr size_t CTL_BYTES = 64 * 1024;
constexpr size_t WS_MOD   = WS_CTL + CTL_BYTES;
constexpr size_t WS_S5P   = WS_MOD + al256((size_t)DEPTH * BATCH * ADA * 4);
constexpr size_t WS_LB    = WS_S5P + al256((size_t)DEPTH * 32 * 64 * 36 * 4);
constexpr size_t WS_BCAT  = WS_LB + al256((size_t)DEPTH * BW * 4);
constexpr size_t WS_WBT   = WS_BCAT + (size_t)DEPTH * NCAT * D * 2;
constexpr size_t WS_WOT   = WS_WBT + (size_t)DEPTH * 4 * D * BW * 2;
constexpr size_t WS_WQT   = WS_WOT + (size_t)DEPTH * D * D * 2;
constexpr size_t WS_WGLUT = WS_WQT + (size_t)DEPTH * D * D * 2;
constexpr size_t WS_POOLT = WS_WGLUT + (size_t)DEPTH * BW * BW * 2;
constexpr size_t WS_KEYST = WS_POOLT + (size_t)DEPTH * BW * BW * 2;
constexpr size_t WS_PU8   = WS_KEYST + (size_t)DEPTH * D * 256 * 2;
constexpr size_t WS_PV8   = WS_PU8 + (size_t)DEPTH * NEXP * D;
constexpr size_t WS_SU    = WS_PV8 + (size_t)DEPTH * NEXP * D;
constexpr size_t WS_SV    = WS_SU + (size_t)DEPTH * NEXP * 4;
constexpr size_t WS_H     = WS_SV + (size_t)DEPTH * NEXP * 4;
constexpr size_t WS_PROJ  = WS_H + (size_t)M * D * 2;
constexpr size_t WS_G8    = WS_PROJ + (size_t)M * INC * 2;
constexpr size_t WS_YG    = WS_G8 + (size_t)M * 4 * D;
constexpr size_t WS_POOLED= WS_YG + (size_t)M * BW * 2;
constexpr size_t WS_EIDX  = WS_POOLED + (size_t)M * BW * 2;
constexpr size_t WS_GATE  = WS_EIDX + (size_t)M * 128 * 4;
constexpr size_t WS_YCAT  = WS_GATE + (size_t)M * 128 * 4;
constexpr size_t WS_END   = WS_YCAT + (size_t)M * D * 2;
constexpr size_t WS_RSS   = WS_PROJ + (size_t)M * D * 2;
constexpr size_t WS_C0    = WS_RSS + (size_t)M * 8;
constexpr float RSS_SCALE = 16777216.0f, RSS_INV = 1.0f / 16777216.0f;
constexpr size_t WS_SD    = WS_C0 + (size_t)BATCH * D * 4;
static_assert(WS_SD + (size_t)BATCH * NEXP * 4 <= WS_PROJ + (size_t)M * INC * 2, "aux tables must fit in the tail of PROJ");

constexpr int LDS_BYTES = 147456, MISC_OFF = 131072;
constexpr int CTR_WORD0 = 4096;

struct Params {
    const float *x, *c, *ada_w, *ada_b, *nmg, *nfg, *w_in, *lam_re, *lam_im, *log_step, *b_re, *b_im, *c_re, *c_im, *s5_d, *w_glu, *b_glu,
                *lb_logits, *hg_gain, *pool_w, *pool_scale, *w_gate, *w_branch, *w_out, *wq, *sub_keys, *peer_u, *peer_v, *final_gain;
    float* out; unsigned char* ws; int ph_lo, ph_hi;
};

struct Ctx { LAS unsigned char* lds; volatile LAS unsigned* misc; int tid, lane, wid, G; unsigned* ctl; };

__device__ __forceinline__ Ctx fresh(const Ctx& F) { Ctx R = F; int t = threadIdx.x; asm volatile("" : "+v"(t)); R.tid = t; R.lane = t & 63; R.wid = __builtin_amdgcn_readfirstlane(t >> 6); return R; }
__device__ __forceinline__ int next_item(const Ctx& F, int ctr, unsigned inc = 1u) {
    __syncthreads();
    if (F.tid == 0) F.misc[8] = __hip_atomic_fetch_add(F.ctl + CTR_WORD0 + 64 * ctr, inc, __ATOMIC_RELAXED, __HIP_MEMORY_SCOPE_AGENT);
    __syncthreads();
    return (int)F.misc[8];
}

__device__ __forceinline__ void pro_mod(const Ctx& F, const Params& p, int it) {
    const int l = it / 48, cb = it % 48;
    LAS float* cond = (LAS float*)F.lds;
    for (int i = F.tid; i < BATCH * D; i += 512) { const int b = i / D, k = i % D; const float v = p.c[i]; cond[k * 16 + b] = siluf_(v); }
    __syncthreads();
    float acc[16][4];
#pragma unroll
    for (int b = 0; b < 16; ++b)
#pragma unroll
        for (int j = 0; j < 4; ++j) acc[b][j] = 0.f;
    const int col = cb * 256 + F.lane * 4;
    const float* wp = p.ada_w + (size_t)l * D * ADA + col;
    const int k0 = F.wid * 256;
#pragma unroll 4
    for (int kk = 0; kk < 256; ++kk) {
        const int k = k0 + kk;
        const f32x4 w = __builtin_nontemporal_load((const f32x4*)(wp + (size_t)k * ADA));
        const LAS f32x4* cp = (const LAS f32x4*)(cond + k * 16);
#pragma unroll
        for (int q = 0; q < 4; ++q) { const f32x4 cv = cp[q];
#pragma unroll
            for (int r = 0; r < 4; ++r)
#pragma unroll
                for (int j = 0; j < 4; ++j) acc[q * 4 + r][j] += cv[r] * w[j]; }
    }
    __syncthreads();
    LAS float* red = (LAS float*)F.lds;
#pragma unroll
    for (int b = 0; b < 16; ++b)
#pragma unroll
        for (int j = 0; j < 4; ++j) red[(F.wid * 16 + b) * 256 + F.lane * 4 + j] = acc[b][j];
    __syncthreads();
    for (int o = F.tid; o < 16 * 256; o += 512) { const int b = o / 256, cc = o % 256; float s = 0.f;
#pragma unroll
        for (int w = 0; w < 8; ++w) s += red[(w * 16 + b) * 256 + cc];
        const int n = cb * 256 + cc;
        ((float*)(p.ws + WS_MOD))[((size_t)l * BATCH + b) * ADA + n] = s + p.ada_b[(size_t)l * ADA + n]; }
}
__device__ __forceinline__ void pro_transpose_tile(const Ctx& F, const float* src, int N, bf16_t* dst, int ldd, int k0, int n0) {
    LAS float* tile = (LAS float*)F.lds;
#pragma unroll
    for (int ps = 0; ps < 4; ++ps) { const int row = ps * 32 + (F.tid >> 4), c4 = (F.tid & 15) * 4;
        const f32x4 v = __builtin_nontemporal_load((const f32x4*)(src + (size_t)(k0 + row) * N + n0 + c4));
        tile[row * 65 + c4 + 0] = v[0]; tile[row * 65 + c4 + 1] = v[1]; tile[row * 65 + c4 + 2] = v[2]; tile[row * 65 + c4 + 3] = v[3]; }
    __syncthreads();
    const int n = F.tid >> 3, ks = (F.tid & 7) * 16;
    unsigned w[8];
#pragma unroll
    for (int i = 0; i < 8; ++i) w[i] = cvt_pk_bf16(tile[(ks + 2 * i) * 65 + n], tile[(ks + 2 * i + 1) * 65 + n]);
    u32x4* dp = (u32x4*)(dst + (size_t)(n0 + n) * ldd + k0 + ks);
    dp[0] = (u32x4){w[0], w[1], w[2], w[3]}; dp[1] = (u32x4){w[4], w[5], w[6], w[7]};
}
constexpr int TT_WIN = 16 * 72, TT_GATE = 16 * 32, TT_BR = 4 * 32, TT_SQ = 16 * 32, TT_GLU = 4 * 8;
constexpr int TT_LAYER = TT_WIN + 4 * TT_GATE + 4 * TT_BR + TT_SQ + TT_GLU;
__device__ __forceinline__ void pro_transpose(const Ctx& F, const Params& p, int it) {
    const int l = it / TT_LAYER; int r = it % TT_LAYER;
    const float* src; int N; bf16_t* dst; int ldd; int ntn;
    if (r < TT_WIN) { src = p.w_in + (size_t)l * D * INC; N = INC; dst = (bf16_t*)(p.ws + WS_BCAT) + (size_t)l * NCAT * D; ldd = D; ntn = 72; }
    else if ((r -= TT_WIN) < 4 * TT_GATE) { const int j = r / TT_GATE; r %= TT_GATE; src = p.w_gate + ((size_t)l * 4 + j) * D * D; N = D; dst = (bf16_t*)(p.ws + WS_BCAT) + ((size_t)l * NCAT + INC + (size_t)j * D) * D; ldd = D; ntn = 32; }
    else if ((r -= 4 * TT_GATE) < 4 * TT_BR) { const int j = r / TT_BR; r %= TT_BR; src = p.w_branch + ((size_t)l * 4 + j) * BW * D; N = D; dst = (bf16_t*)(p.ws + WS_WBT) + (size_t)l * D * D + (size_t)j * BW; ldd = D; ntn = 32; }
    else if ((r -= 4 * TT_BR) < TT_SQ) { src = p.w_out + (size_t)l * D * D; N = D; dst = (bf16_t*)(p.ws + WS_WOT) + (size_t)l * D * D; ldd = D; ntn = 32; }
    else { r -= TT_SQ; src = p.w_glu + (size_t)l * BW * BW; N = BW; dst = (bf16_t*)(p.ws + WS_WGLUT) + (size_t)l * BW * BW; ldd = BW; ntn = 8; }
    const int tk = r / ntn, tn = r % ntn;
    pro_transpose_tile(F, src, N, dst, ldd, tk * 128, tn * 64);
}
__device__ __forceinline__ void pro_qk(const Ctx& F, const Params& p, int it) {
    const int l = it >> 9, r = it & 511, kb = r >> 4, hp = r & 15;
    LAS float* qs = (LAS float*)F.lds;
    LAS float* ks = qs + 64 * 132;
    const float* wq = p.wq + (size_t)l * D * D + (size_t)(kb * 64) * D + hp * 128;
    const float* ky = p.sub_keys + ((size_t)l * 16 + hp) * 128 * 128;
    for (int i = F.tid; i < 64 * 32; i += 512) { const int row = i >> 5, c4 = (i & 31) * 4; *(LAS f32x4*)(qs + row * 132 + c4) = __builtin_nontemporal_load((const f32x4*)(wq + (size_t)row * D + c4)); }
    for (int i = F.tid; i < 128 * 32; i += 512) { const int row = i >> 5, c4 = (i & 31) * 4; *(LAS f32x4*)(ks + row * 132 + c4) = *(const f32x4*)(ky + (size_t)row * 128 + c4); }
    __syncthreads();
    const int fr = F.lane & 15, fq = F.lane >> 4, kblk = F.wid & 3, nb0 = (F.wid >> 2) * 4;
    f32x4 acc[4];
#pragma unroll
    for (int nb = 0; nb < 4; ++nb) acc[nb] = (f32x4){0.f, 0.f, 0.f, 0.f};
#pragma unroll
    for (int kk = 0; kk < 4; ++kk) {
        const LAS float* ap = qs + (kblk * 16 + fr) * 132 + kk * 32 + fq * 8;
        const f32x4 a0 = *(const LAS f32x4*)ap, a1 = *(const LAS f32x4*)(ap + 4);
        const u32x4 aw = (u32x4){cvt_pk_bf16(a0[0], a0[1]), cvt_pk_bf16(a0[2], a0[3]), cvt_pk_bf16(a1[0], a1[1]), cvt_pk_bf16(a1[2], a1[3])};
#pragma unroll
        for (int nb = 0; nb < 4; ++nb) {
            const LAS float* bp = ks + ((nb0 + nb) * 16 + fr) * 132 + kk * 32 + fq * 8;
            const f32x4 b0 = *(const LAS f32x4*)bp, b1 = *(const LAS f32x4*)(bp + 4);
            const u32x4 bw = (u32x4){cvt_pk_bf16(b0[0], b0[1]), cvt_pk_bf16(b0[2], b0[3]), cvt_pk_bf16(b1[0], b1[1]), cvt_pk_bf16(b1[2], b1[3])};
            acc[nb] = __builtin_amdgcn_mfma_f32_16x16x32_bf16(__builtin_bit_cast(bf16x8, aw), __builtin_bit_cast(bf16x8, bw), acc[nb], 0, 0, 0); } }
#pragma unroll
    for (int nb = 0; nb < 4; ++nb) {
        bf16_t* dst = (bf16_t*)(p.ws + WS_WQT) + ((size_t)l * D + hp * 128 + (nb0 + nb) * 16 + fr) * D + kb * 64 + kblk * 16 + 4 * fq;
        *(u32x2*)dst = (u32x2){cvt_pk_bf16(acc[nb][0], acc[nb][1]), cvt_pk_bf16(acc[nb][2], acc[nb][3])}; }
}
__device__ __forceinline__ void pro_small(const Ctx& F, const Params& p, int it) {
    if (it < 1024) {
        const int o = it * 512 + F.tid, l = o >> 18, r = o & 262143, n = r >> 9, k = r & 511, g = n >> 7, d = n & 127, g2 = k >> 7, c = k & 127;
        const float v = (g == g2) ? p.pool_w[(((size_t)l * 4 + g) * 128 + c) * 128 + d] * p.pool_scale[l * BW + n] : 0.f;
        ((bf16_t*)(p.ws + WS_POOLT))[o] = f2bf(v);
    } else if (it < 1024 + 2048) {
    } else if (it < 1024 + 2048 + 8) {
        const int o = (it - 3072) * 512 + F.tid, l = o >> 11, g = (o >> 6) & 31;
        const float lr = fminf(p.lam_re[o], -1e-4f), li = p.lam_im[o], step = expf(p.log_step[l * 32 + g]);
        const float mag = expf(lr * step); float sn, cs; sincosf(li * step, &sn, &cs);
        const float are = mag * cs, aim = mag * sn, den = lr * lr + li * li, nr = are - 1.0f;
        const float fr = (nr * lr + aim * li) / den, fi = (aim * lr - nr * li) / den;
        float* q = (float*)(p.ws + WS_S5P) + (size_t)o * 36;
        q[0] = are; q[1] = aim; q[2] = 0.f; q[3] = 0.f;
#pragma unroll
        for (int h = 0; h < 16; ++h) { const float br = p.b_re[(size_t)o * 16 + h], bi = p.b_im[(size_t)o * 16 + h]; q[4 + h] = fr * br - fi * bi; q[20 + h] = fr * bi + fi * br; }
    } else {
        const int o = (it - 3080) * 512 + F.tid, l = o >> 9, j = o & 511;
        const float a0 = p.lb_logits[j], a1 = p.lb_logits[BW + j];
        ((float*)(p.ws + WS_LB))[o] = (l == 0) ? 0.f : 1.0f / (1.0f + expf(a0 - a1));
    }
}
__device__ __forceinline__ void pro_peer(const Ctx& F, const Params& p, int it) {
    const int row = it * 8 + F.wid, tb = row >> 15, le = row & 32767, l = le >> 14, e = le & 16383;
    const float* src = (tb ? p.peer_v : p.peer_u) + (size_t)le * D;
    f32x4 v[8]; float am = 0.f;
#pragma unroll
    for (int i = 0; i < 4; ++i) { v[2 * i] = __builtin_nontemporal_load((const f32x4*)(src + i * 512 + F.lane * 8)); v[2 * i + 1] = __builtin_nontemporal_load((const f32x4*)(src + i * 512 + F.lane * 8 + 4)); }
#pragma unroll
    for (int i = 0; i < 8; ++i) am = fmaxf(fmaxf(am, fmaxf(fabsf(v[i][0]), fabsf(v[i][1]))), fmaxf(fabsf(v[i][2]), fabsf(v[i][3])));
#pragma unroll
    for (int o = 32; o >= 1; o >>= 1) am = fmaxf(am, __shfl_xor(am, o));
    const float scale = am > 0.f ? am * (1.0f / 440.0f) : 1.0f, inv = 1.0f / scale;
    unsigned char* T8 = p.ws + (tb ? WS_PV8 : WS_PU8) + (size_t)l * 16 * NEXP * 128;
#pragma unroll
    for (int i = 0; i < 4; ++i) { const int slice = 4 * i + (F.lane >> 4), off = (F.lane & 15) * 8; int w0 = 0, w1 = 0;
        w0 = __builtin_amdgcn_cvt_pk_fp8_f32(v[2 * i][0] * inv, v[2 * i][1] * inv, w0, false); w0 = __builtin_amdgcn_cvt_pk_fp8_f32(v[2 * i][2] * inv, v[2 * i][3] * inv, w0, true);
        w1 = __builtin_amdgcn_cvt_pk_fp8_f32(v[2 * i + 1][0] * inv, v[2 * i + 1][1] * inv, w1, false); w1 = __builtin_amdgcn_cvt_pk_fp8_f32(v[2 * i + 1][2] * inv, v[2 * i + 1][3] * inv, w1, true);
        *(u32x2*)(T8 + ((size_t)slice * NEXP + e) * 128 + off) = (u32x2){(unsigned)w0, (unsigned)w1}; }
    if (F.lane == 0) ((float*)(p.ws + (tb ? WS_SV : WS_SU)))[le] = scale;
}
constexpr int PRO_MOD = 96, PRO_TT = 2 * TT_LAYER, PRO_SMALL = 1024 + 2048 + 8 + 2, PRO_PEER = 2 * DEPTH * NEXP / 8, PRO_QK = DEPTH * 512;
__device__ __forceinline__ void phase_prologue(const Ctx& F, const Params& p) {
    for (;;) { const int it = next_item(F, 0); if (it >= PRO_MOD) break; pro_mod(F, p, it); }
    constexpr int PRO_REST = PRO_QK + PRO_TT + PRO_SMALL + PRO_PEER;
    for (;;) {
        const int base = next_item(F, 3, 4u);
        if (base >= PRO_REST) break;
#pragma unroll 1
        for (int q = 0; q < 4; ++q) { int it = base + q; if (it >= PRO_REST) break;
            __syncthreads();
            if (it < PRO_QK) pro_qk(F, p, it);
            else if ((it -= PRO_QK) < PRO_TT) pro_transpose(F, p, it);
            else if ((it -= PRO_TT) < PRO_SMALL) pro_small(F, p, it);
            else pro_peer(F, p, it - PRO_SMALL); }
    }
}

template <int MODE>
__device__ __forceinline__ void norm_row(const Ctx& F, int r, const float* xin, const float* gain, const float* sh, const float* sc, bf16_t* hout, float* fout) {
    {
        const int b = r / SEQ;
        const f32x4* xp = (const f32x4*)(xin + (size_t)r * D);
        f32x4 v[8]; float ss = 0.f;
#pragma unroll
        for (int i = 0; i < 8; ++i) { v[i] = xp[i * 64 + F.lane]; ss += v[i][0] * v[i][0] + v[i][1] * v[i][1] + v[i][2] * v[i][2] + v[i][3] * v[i][3]; }
#pragma unroll
        for (int o = 32; o >= 1; o >>= 1) ss += __shfl_xor(ss, o);
        const float rs = rsqrtf(ss * (1.0f / D) + EPS);
#pragma unroll
        for (int i = 0; i < 8; ++i) { const int c = (i * 64 + F.lane) * 4; const f32x4 g = *(const f32x4*)(gain + c); f32x4 y = v[i] * rs * g;
            if (MODE == 0) { const f32x4 s1 = *(const f32x4*)(sc + (size_t)b * ADA + c), s0 = *(const f32x4*)(sh + (size_t)b * ADA + c); y = y * (s1 + 1.0f) + s0;
                *(u32x2*)(hout + (size_t)r * D + c) = (u32x2){cvt_pk_bf16(y[0], y[1]), cvt_pk_bf16(y[2], y[3])}; }
            else *(f32x4*)(fout + (size_t)r * D + c) = y; }
    }
}
template <int MODE, int NR>
__device__ __forceinline__ void norm_rows(const Ctx& F, int r, const float* xin, const float* gain, const float* sh, const float* sc, bf16_t* hout, float* fout) {
    const int b = r / SEQ;
    const f32x4* xp = (const f32x4*)(xin + (size_t)r * D);
    f32x4 v[NR][8]; float ss[NR];
#pragma unroll
    for (int i = 0; i < 8; ++i)
#pragma unroll
        for (int q = 0; q < NR; ++q) v[q][i] = xp[q * (D / 4) + i * 64 + F.lane];
#pragma unroll
    for (int q = 0; q < NR; ++q) { float a = 0.f;
#pragma unroll
        for (int i = 0; i < 8; ++i) a += v[q][i][0] * v[q][i][0] + v[q][i][1] * v[q][i][1] + v[q][i][2] * v[q][i][2] + v[q][i][3] * v[q][i][3];
        ss[q] = a; }
#pragma unroll
    for (int o = 32; o >= 1; o >>= 1)
#pragma unroll
        for (int q = 0; q < NR; ++q) ss[q] += __shfl_xor(ss[q], o);
#pragma unroll
    for (int q = 0; q < NR; ++q) ss[q] = rsqrtf(ss[q] * (1.0f / D) + EPS);
#pragma unroll
    for (int i = 0; i < 8; ++i) { const int c = (i * 64 + F.lane) * 4; const f32x4 g = *(const f32x4*)(gain + c);
        f32x4 s1, s0; if (MODE == 0) { s1 = *(const f32x4*)(sc + (size_t)b * ADA + c) + 1.0f; s0 = *(const f32x4*)(sh + (size_t)b * ADA + c); }
#pragma unroll
        for (int q = 0; q < NR; ++q) { f32x4 y = v[q][i] * ss[q] * g;
            if (MODE == 0) { y = y * s1 + s0; *(u32x2*)(hout + (size_t)(r + q) * D + c) = (u32x2){cvt_pk_bf16(y[0], y[1]), cvt_pk_bf16(y[2], y[3])}; }
            else *(f32x4*)(fout + (size_t)(r + q) * D + c) = y; } }
}
template <int MODE>
__device__ __forceinline__ void phase_norm(const Ctx& F, const float* xin, const float* gain, const float* sh, const float* sc, bf16_t* hout, float* fout) {
    for (int r = (blockIdx.x * 8 + F.wid) * 4; r < M; r += F.G * 32) norm_rows<MODE, 4>(F, r, xin, gain, sh, sc, hout, fout);
}

struct EpiGateT {
    static constexpr bool PERM = true; static constexpr bool KHOOK = false;
    unsigned char* g8;
    __device__ __forceinline__ void operator()(const f32x4 (&acc)[2][2][4][2], const pg8::Unit& u, int wr, int wc, int fr, int fq) const {
        unsigned char* tp = g8 + ((size_t)(u.pm * 32 + u.pn) * 512 + (size_t)((wr * 4 + wc) * 64 + fq * 16 + fr)) * 128;
#pragma unroll
        for (int ai = 0; ai < 2; ++ai)
#pragma unroll
            for (int m = 0; m < 4; ++m) { unsigned w[2][2];
#pragma unroll
                for (int bj = 0; bj < 2; ++bj)
#pragma unroll
                    for (int n = 0; n < 2; ++n) { const f32x4 v = acc[ai][bj][m][n]; unsigned q = 0;
#pragma unroll
                        for (int j = 0; j < 4; ++j) { const unsigned b = (unsigned)fminf(__builtin_amdgcn_rcpf(__builtin_fmaf(__expf(-v[j]), 0.00390625f, 0.00390625f)), 255.0f); q |= b << (8 * j); }
                        w[bj][n] = q; }
                *(u32x4*)(tp + (ai * 4 + m) * 16) = (u32x4){w[0][0], w[0][1], w[1][0], w[1][1]}; }
    }
};
struct EpiGlu {
    static constexpr bool PERM = true; static constexpr bool KHOOK = false;
    const bf16_t* yg; const float* bglu; bf16_t* ycat;
    __device__ __forceinline__ void operator()(const f32x4 (&acc)[2][2][4][2], const pg8::Unit& u, int wr, int wc, int fr, int fq) const {
        const int row0 = u.pm * 256 + wr * 64 + fr, col0 = u.pn * 256 + wc * 32 + 8 * fq;
        f32x4 bq[2][2];
#pragma unroll
        for (int bj = 0; bj < 2; ++bj) { bq[bj][0] = *(const f32x4*)(bglu + col0 + bj * 128); bq[bj][1] = *(const f32x4*)(bglu + col0 + bj * 128 + 4); }
#pragma unroll
        for (int ai = 0; ai < 2; ++ai) {
            u32x4 yq[4][2];
#pragma unroll
            for (int m = 0; m < 4; ++m)
#pragma unroll
                for (int bj = 0; bj < 2; ++bj) yq[m][bj] = *(const u32x4*)(yg + (size_t)(row0 + ai * 128 + m * 16) * BW + col0 + bj * 128);
#pragma unroll
            for (int m = 0; m < 4; ++m) { const size_t row = (size_t)(row0 + ai * 128 + m * 16);
#pragma unroll
                for (int bj = 0; bj < 2; ++bj) { const int col = col0 + bj * 128;
                    const u32x4 yv = yq[m][bj]; const f32x4 b0 = bq[bj][0], b1 = bq[bj][1];
                    const f32x4 v0 = acc[ai][bj][m][0] + b0, v1 = acc[ai][bj][m][1] + b1;
                    float o[8]; o[0] = bflo(yv[0]) * sigmoidf_(v0[0]); o[1] = bfhi(yv[0]) * sigmoidf_(v0[1]); o[2] = bflo(yv[1]) * sigmoidf_(v0[2]); o[3] = bfhi(yv[1]) * sigmoidf_(v0[3]);
                    o[4] = bflo(yv[2]) * sigmoidf_(v1[0]); o[5] = bfhi(yv[2]) * sigmoidf_(v1[1]); o[6] = bflo(yv[3]) * sigmoidf_(v1[2]); o[7] = bfhi(yv[3]) * sigmoidf_(v1[3]);
                    *(u32x4*)(ycat + row * D + col) = (u32x4){cvt_pk_bf16(o[0], o[1]), cvt_pk_bf16(o[2], o[3]), cvt_pk_bf16(o[4], o[5]), cvt_pk_bf16(o[6], o[7])}; } } }
    }
};
struct EpiBf16 {
    static constexpr bool PERM = true; static constexpr bool KHOOK = false;
    bf16_t* O; int ldc; int coff;
    __device__ __forceinline__ void operator()(const f32x4 (&acc)[2][2][4][2], const pg8::Unit& u, int wr, int wc, int fr, int fq) const {
        const int row0 = u.pm * 256 + wr * 64 + fr, col0 = coff + u.pn * 256 + wc * 32 + 8 * fq;
#pragma unroll
        for (int ai = 0; ai < 2; ++ai)
#pragma unroll
            for (int m = 0; m < 4; ++m) { bf16_t* rowp = O + (size_t)(row0 + ai * 128 + m * 16) * ldc + col0;
#pragma unroll
                for (int bj = 0; bj < 2; ++bj) { const f32x4 v0 = acc[ai][bj][m][0], v1 = acc[ai][bj][m][1];
                    *(u32x4*)(rowp + bj * 128) = (u32x4){cvt_pk_bf16(v0[0], v0[1]), cvt_pk_bf16(v0[2], v0[3]), cvt_pk_bf16(v1[0], v1[1]), cvt_pk_bf16(v1[2], v1[3])}; } }
    }
};
struct EpiMerge {
    static constexpr bool PERM = true; static constexpr bool KHOOK = true;
    const unsigned char* g8; bf16_t* mg;
    __device__ __forceinline__ const unsigned char* tile(const pg8::Unit& u, int n, int wr, int wc, int fr, int fq) const {
        return g8 + ((size_t)(u.pm * 32 + n * 8 + u.pn) * 512 + (size_t)((wr * 4 + wc) * 64 + fq * 16 + fr)) * 128; }
    __device__ __forceinline__ void khook(f32x4 (&acc)[2][2][4][2], const pg8::Unit& u, int j, int wr, int wc, int fr, int fq) const {
        const unsigned char* ta = tile(u, j - 1, wr, wc, fr, fq); const unsigned char* tb = tile(u, j, wr, wc, fr, fq);
        u32x4 ga[2], gb[2];
        ga[0] = *(const u32x4*)ta; gb[0] = *(const u32x4*)tb; ga[1] = *(const u32x4*)(ta + 16); gb[1] = *(const u32x4*)(tb + 16);
#pragma unroll
        for (int q = 0; q < 8; ++q) { const int ai = q >> 2, m = q & 3; const u32x4 a4 = ga[q & 1], b4 = gb[q & 1];
            if (q + 2 < 8) { ga[q & 1] = *(const u32x4*)(ta + (q + 2) * 16); gb[q & 1] = *(const u32x4*)(tb + (q + 2) * 16); }
#pragma unroll
            for (int bj = 0; bj < 2; ++bj)
#pragma unroll
                for (int n = 0; n < 2; ++n) { const unsigned wa = a4[bj * 2 + n], wb = b4[bj * 2 + n];
#pragma unroll
                    for (int jj = 0; jj < 4; ++jj) acc[ai][bj][m][n][jj] *= ((float)((wa >> (8 * jj)) & 255u) + 0.5f) * __builtin_amdgcn_rcpf((float)((wb >> (8 * jj)) & 255u) + 0.5f); } }
    }
    __device__ __forceinline__ void operator()(const f32x4 (&acc)[2][2][4][2], const pg8::Unit& u, int wr, int wc, int fr, int fq) const {
        const int row0 = u.pm * 256 + wr * 64 + fr, col0 = u.pn * 256 + wc * 32 + 8 * fq;
        const unsigned char* tp = tile(u, 3, wr, wc, fr, fq);
        u32x4 gq[8];
#pragma unroll
        for (int q = 0; q < 8; ++q) gq[q] = *(const u32x4*)(tp + q * 16);
#pragma unroll
        for (int q = 0; q < 8; ++q) { const int ai = q >> 2, m = q & 3; const size_t row = (size_t)(row0 + ai * 128 + m * 16); const u32x4 g4 = gq[q];
#pragma unroll
            for (int bj = 0; bj < 2; ++bj) { const f32x4 v0 = acc[ai][bj][m][0], v1 = acc[ai][bj][m][1]; float o[8];
#pragma unroll
                for (int jj = 0; jj < 4; ++jj) { o[jj] = v0[jj] * __builtin_fmaf((float)((g4[bj * 2] >> (8 * jj)) & 255u), 1.0f / 256.0f, 0.5f / 256.0f); o[4 + jj] = v1[jj] * __builtin_fmaf((float)((g4[bj * 2 + 1] >> (8 * jj)) & 255u), 1.0f / 256.0f, 0.5f / 256.0f); }
                *(u32x4*)(mg + row * D + col0 + bj * 128) = (u32x4){cvt_pk_bf16(o[0], o[1]), cvt_pk_bf16(o[2], o[3]), cvt_pk_bf16(o[4], o[5]), cvt_pk_bf16(o[6], o[7])}; } }
    }
};
struct EpiResid {
    static constexpr bool PERM = false; static constexpr bool KHOOK = false;
    const float* xin; const float* gvec; float* xout;
    __device__ __forceinline__ void operator()(const f32x4 (&acc)[2][2][4][2], const pg8::Unit& u, int wr, int wc, int fr, int fq) const {
        const int row0 = u.pm * 256 + wr * 64 + fr, col0 = u.pn * 256 + wc * 32 + 4 * fq, b = u.pm / 8;
        f32x4 gv[2][2];
#pragma unroll
        for (int bj = 0; bj < 2; ++bj)
#pragma unroll
            for (int n = 0; n < 2; ++n) gv[bj][n] = *(const f32x4*)(gvec + (size_t)b * ADA + col0 + bj * 128 + n * 16);
        f32x4 xv[2][4];
#pragma unroll
        for (int q = 0; q < 2; ++q)
#pragma unroll
            for (int c = 0; c < 4; ++c) xv[q][c] = *(const f32x4*)(xin + (size_t)(row0 + (q >> 2) * 128 + (q & 3) * 16) * D + col0 + (c >> 1) * 128 + (c & 1) * 16);
#pragma unroll
        for (int q = 0; q < 8; ++q) { const int ai = q >> 2, m = q & 3; const size_t off = (size_t)(row0 + ai * 128 + m * 16) * D + col0;
            f32x4 cur[4];
#pragma unroll
            for (int c = 0; c < 4; ++c) cur[c] = xv[q & 1][c];
            if (q + 2 < 8) {
#pragma unroll
                for (int c = 0; c < 4; ++c) xv[q & 1][c] = *(const f32x4*)(xin + (size_t)(row0 + ((q + 2) >> 2) * 128 + ((q + 2) & 3) * 16) * D + col0 + (c >> 1) * 128 + (c & 1) * 16); }
#pragma unroll
            for (int c = 0; c < 4; ++c) *(f32x4*)(xout + off + (c >> 1) * 128 + (c & 1) * 16) = cur[c] + gv[c >> 1][c & 1] * acc[ai][c >> 1][m][c & 1];
        }
    }
};
struct EpiResidN {
    static constexpr bool PERM = true; static constexpr bool KHOOK = false;
    const float* xin; const float* gvec; float* xout; const float* gain; const float* sc; bf16_t* hraw; unsigned long long* rss;
    __device__ __forceinline__ void operator()(const f32x4 (&acc)[2][2][4][2], const pg8::Unit& u, int wr, int wc, int fr, int fq) const {
        const int row0 = u.pm * 256 + wr * 64 + fr, col0 = u.pn * 256 + wc * 32 + 8 * fq, b = u.pm / 8;
        float ssq[8];
#pragma unroll
        for (int bj = 0; bj < 2; ++bj) { const int cb = col0 + bj * 128;
            const f32x4 gv0 = *(const f32x4*)(gvec + (size_t)b * ADA + cb), gv1 = *(const f32x4*)(gvec + (size_t)b * ADA + cb + 4);
            const f32x4 wm0 = *(const f32x4*)(gain + cb) * (*(const f32x4*)(sc + (size_t)b * ADA + cb) + 1.0f), wm1 = *(const f32x4*)(gain + cb + 4) * (*(const f32x4*)(sc + (size_t)b * ADA + cb + 4) + 1.0f);
            f32x4 xv[4][2];
#pragma unroll
            for (int q = 0; q < 4; ++q) { const float* xp = xin + (size_t)(row0 + (q >> 2) * 128 + (q & 3) * 16) * D + cb; xv[q][0] = __builtin_nontemporal_load((const f32x4*)xp); xv[q][1] = __builtin_nontemporal_load((const f32x4*)(xp + 4)); }
#pragma unroll
            for (int q = 0; q < 8; ++q) { const int ai = q >> 2, m = q & 3; const size_t off = (size_t)(row0 + ai * 128 + m * 16) * D + cb;
                f32x4 o0 = xv[q & 3][0], o1 = xv[q & 3][1];
                if (q + 4 < 8) { const float* xp = xin + (size_t)(row0 + ((q + 4) >> 2) * 128 + ((q + 4) & 3) * 16) * D + cb; xv[q & 3][0] = __builtin_nontemporal_load((const f32x4*)xp); xv[q & 3][1] = __builtin_nontemporal_load((const f32x4*)(xp + 4)); }
                o0 = o0 + gv0 * acc[ai][bj][m][0]; o1 = o1 + gv1 * acc[ai][bj][m][1];
                *(f32x4*)(xout + off) = o0; *(f32x4*)(xout + off + 4) = o1;
                const float ss = (o0[0] * o0[0] + o0[1] * o0[1] + o0[2] * o0[2] + o0[3] * o0[3]) + (o1[0] * o1[0] + o1[1] * o1[1] + o1[2] * o1[2] + o1[3] * o1[3]);
                ssq[q] = bj == 0 ? ss : ssq[q] + ss;
                const f32x4 y0 = o0 * wm0, y1 = o1 * wm1;
                *(u32x4*)(hraw + off) = (u32x4){cvt_pk_bf16(y0[0], y0[1]), cvt_pk_bf16(y0[2], y0[3]), cvt_pk_bf16(y1[0], y1[1]), cvt_pk_bf16(y1[2], y1[3])}; } }
#pragma unroll
        for (int q = 0; q < 8; ++q) { float ss = ssq[q]; ss += __shfl_xor(ss, 16); ss += __shfl_xor(ss, 32);
            if (fq == 0) (void)__hip_atomic_fetch_add(rss + row0 + (q >> 2) * 128 + (q & 3) * 16, (unsigned long long)(ss * RSS_SCALE), __ATOMIC_RELAXED, __HIP_MEMORY_SCOPE_AGENT); }
    }
};
struct EpiScore {
    static constexpr bool PERM = true; static constexpr bool KHOOK = false;
    bf16_t* C; const unsigned long long* rss; const float* c0;
    __device__ __forceinline__ void operator()(const f32x4 (&acc)[2][2][4][2], const pg8::Unit& u, int wr, int wc, int fr, int fq) const {
        const int row0 = u.pm * 256 + wr * 64 + fr, col0 = u.pn * 256 + wc * 32 + 8 * fq, b = u.pm / 8;
        f32x4 cv[2][2];
#pragma unroll
        for (int bj = 0; bj < 2; ++bj)
#pragma unroll
            for (int n = 0; n < 2; ++n) cv[bj][n] = *(const f32x4*)(c0 + (size_t)b * D + col0 + bj * 128 + n * 4);
        unsigned long long rq[8];
#pragma unroll
        for (int q = 0; q < 8; ++q) rq[q] = rss[row0 + (q >> 2) * 128 + (q & 3) * 16];
#pragma unroll
        for (int ai = 0; ai < 2; ++ai)
#pragma unroll
            for (int m = 0; m < 4; ++m) { const int row = row0 + ai * 128 + m * 16; bf16_t* rowp = C + (size_t)row * D + col0; const float rs = rsqrtf((float)rq[ai * 4 + m] * (RSS_INV / D) + EPS);
#pragma unroll
                for (int bj = 0; bj < 2; ++bj) { const f32x4 v0 = acc[ai][bj][m][0] * rs + cv[bj][0], v1 = acc[ai][bj][m][1] * rs + cv[bj][1];
                    *(u32x4*)(rowp + bj * 128) = (u32x4){cvt_pk_bf16(v0[0], v0[1]), cvt_pk_bf16(v0[2], v0[3]), cvt_pk_bf16(v1[0], v1[1]), cvt_pk_bf16(v1[2], v1[3])}; } }
    }
};
__device__ __forceinline__ void aux_shift_tables(const Ctx& F, const Params& p, int l) {
    const float* sh = (const float*)(p.ws + WS_MOD) + (size_t)l * BATCH * ADA + 3 * D;
    unsigned long long* rss = (unsigned long long*)(p.ws + WS_RSS); float* c0 = (float*)(p.ws + WS_C0); float* sd = (float*)(p.ws + WS_SD);
    LAS unsigned char* shb = F.lds;
    LAS f32x4* red = (LAS f32x4*)(F.lds + 16 * 4112);
    __syncthreads();
    for (int i = blockIdx.x * 512 + F.tid; i < M; i += F.G * 512) rss[i] = 0ull;
    for (int i = F.tid; i < 16 * 512; i += 512) { const int b = i >> 9, c4 = (i & 511) * 4; const f32x4 v = *(const f32x4*)(sh + (size_t)b * ADA + c4);
        *(LAS u32x2*)(shb + b * 4112 + c4 * 2) = (u32x2){cvt_pk_bf16(v[0], v[1]), cvt_pk_bf16(v[2], v[3])}; }
    __syncthreads();
    const int fr = F.lane & 15, fq = F.lane >> 4;
    const LAS unsigned char* ap = shb + fr * 4112 + fq * 16;
    for (int eb = blockIdx.x; eb < NEXP / 64; eb += F.G) {
        const int nb = F.wid & 3, kh = F.wid >> 2, e = eb * 64 + nb * 16 + fr;
        const unsigned char* up = p.ws + WS_PU8 + (size_t)l * 16 * NEXP * 128 + (size_t)e * 128 + fq * 8;
        f32x4 acc = (f32x4){0.f, 0.f, 0.f, 0.f};
#pragma unroll 2
        for (int s = kh * 8; s < kh * 8 + 8; ++s) {
            u32x2 w[4];
#pragma unroll
            for (int kk = 0; kk < 4; ++kk) w[kk] = *(const u32x2*)(up + (size_t)s * NEXP * 128 + kk * 32);
#pragma unroll
            for (int kk = 0; kk < 4; ++kk) {
                const f32x2 a0 = __builtin_amdgcn_cvt_pk_f32_fp8((int)w[kk][0], false), a1 = __builtin_amdgcn_cvt_pk_f32_fp8((int)w[kk][0], true);
                const f32x2 a2 = __builtin_amdgcn_cvt_pk_f32_fp8((int)w[kk][1], false), a3 = __builtin_amdgcn_cvt_pk_f32_fp8((int)w[kk][1], true);
                const u32x4 bw = (u32x4){cvt_pk_bf16(a0[0], a0[1]), cvt_pk_bf16(a1[0], a1[1]), cvt_pk_bf16(a2[0], a2[1]), cvt_pk_bf16(a3[0], a3[1])};
                const bf16x8 af = *(const LAS bf16x8*)(ap + (s * 128 + kk * 32) * 2);
                acc = __builtin_amdgcn_mfma_f32_16x16x32_bf16(af, __builtin_bit_cast(bf16x8, bw), acc, 0, 0, 0); } }
        if (kh == 1) red[(F.wid - 4) * 64 + F.lane] = acc;
        __syncthreads();
        if (kh == 0) { const f32x4 o = acc + red[F.wid * 64 + F.lane];
#pragma unroll
            for (int r = 0; r < 4; ++r) sd[(size_t)(4 * fq + r) * NEXP + e] = o[r]; }
        __syncthreads();
    }
    for (int nbk = blockIdx.x; nbk < D / 16; nbk += F.G) {
        const bf16_t* wp = (const bf16_t*)(p.ws + WS_WQT) + (size_t)l * D * D + (size_t)(nbk * 16 + fr) * D + F.wid * 256 + fq * 8;
        f32x4 acc = (f32x4){0.f, 0.f, 0.f, 0.f};
#pragma unroll
        for (int kk = 0; kk < 8; ++kk) { const bf16x8 bf = *(const bf16x8*)(wp + kk * 32); const bf16x8 af = *(const LAS bf16x8*)(ap + (F.wid * 256 + kk * 32) * 2);
            acc = __builtin_amdgcn_mfma_f32_16x16x32_bf16(af, bf, acc, 0, 0, 0); }
        red[F.wid * 64 + F.lane] = acc;
        __syncthreads();
        if (F.wid == 0) { f32x4 o = red[F.lane];
#pragma unroll
            for (int w = 1; w < 8; ++w) o = o + red[w * 64 + F.lane];
#pragma unroll
            for (int r = 0; r < 4; ++r) c0[(size_t)(4 * fq + r) * D + nbk * 16 + fr] = o[r]; }
        __syncthreads();
    }
}
struct EpiF32 {
    static constexpr bool PERM = false; static constexpr bool KHOOK = false;
    float* C; int ldc;
    __device__ __forceinline__ void operator()(const f32x4 (&acc)[2][2][4][2], const pg8::Unit& u, int wr, int wc, int fr, int fq) const {
        const int row0 = u.pm * 256 + wr * 64 + fr, col0 = u.pn * 256 + wc * 32 + 4 * fq;
#pragma unroll
        for (int ai = 0; ai < 2; ++ai)
#pragma unroll
            for (int m = 0; m < 4; ++m) { float* rowp = C + (size_t)(row0 + ai * 128 + m * 16) * ldc + col0;
#pragma unroll
                for (int bj = 0; bj < 2; ++bj)
#pragma unroll
                    for (int n = 0; n < 2; ++n) *(f32x4*)(rowp + bj * 128 + n * 16) = acc[ai][bj][m][n]; }
    }
};

__device__ __forceinline__ void mix_hgrn2(const Ctx& F, const Params& p, int l, int it) {
    const int b = it >> 2, hd = it & 3;
    const bf16_t* proj = (const bf16_t*)(p.ws + WS_PROJ);
    bf16_t* ycat = (bf16_t*)(p.ws + WS_YCAT);
    const float* lbp = (const float*)(p.ws + WS_LB) + l * BW + hd * 128;
    LAS bf16_t* QH = (LAS bf16_t*)F.lds;
    LAS bf16_t* Q1 = QH + 32 * 136;
    LAS bf16_t* K0 = Q1 + 16 * 136;
    LAS bf16_t* KT = K0 + 16 * 136;
    LAS bf16_t* VT = KT + 128 * 40;
    LAS bf16_t* AM = VT + 128 * 40;
    LAS bf16_t* ST = AM + 32 * 40;
    LAS bf16_t* qsB = ST + 128 * 136;
    LAS bf16_t* kkB = qsB + 32 * 128;
    LAS float* bF = (LAS float*)(kkB + 32 * 128);
    LAS float* OS = bF + 32 * 128;
    LAS float* tot = OS + 32 * 132;
    const int d = F.tid & 127, tq = F.tid >> 7, ln = F.lane, l15 = ln & 15, lq = ln >> 4, w = F.wid;
    const float lb = lbp[d];
    __syncthreads();
    for (int i = F.tid; i < 128 * 136 / 8; i += 512) ((LAS u32x4*)ST)[i] = (u32x4){0u, 0u, 0u, 0u};
    f32x4 accS[8];
#pragma unroll
    for (int nt = 0; nt < 8; ++nt) accS[nt] = (f32x4){0.f, 0.f, 0.f, 0.f};
    unsigned rq[8], rf[8], rv[8];
    { const bf16_t* pr = proj + (size_t)(b * SEQ + tq * 8) * INC + hd * 128 + d;
#pragma unroll
      for (int i = 0; i < 8; ++i) { rq[i] = pr[(size_t)i * INC + 512]; rf[i] = pr[(size_t)i * INC + 1024]; rv[i] = pr[(size_t)i * INC + 1536]; } }
    float gnv[8];
    { const float* gn = p.hg_gain + l * BW + hd * 128 + (F.tid & 15) * 8;
#pragma unroll
      for (int j = 0; j < 8; ++j) gnv[j] = gn[j]; }
    for (int t0 = 0; t0 < SEQ; t0 += 32) {
        const u32x4 gv = *(const u32x4*)(proj + (size_t)(b * SEQ + t0 + (F.tid >> 4)) * INC + 2048 + hd * 128 + (F.tid & 15) * 8);
        float qs[8], kk[8], cs[8], fd[8]; unsigned vraw[8];
        { float run = 0.f;
#pragma unroll
          for (int i = 0; i < 8; ++i) { const float qv = bf2f(rq[i]), fv = bf2f(rf[i]); vraw[i] = rv[i];
              const float fg = lb + (1.0f - lb) * sigmoidf_(fv); fd[i] = fmaxf(fg, 1e-6f); run += __logf(fd[i]); cs[i] = run; kk[i] = 1.0f - fg; qs[i] = siluf_(qv); }
          tot[tq * 128 + d] = run;
          const int tn0 = (t0 + 32 < SEQ) ? t0 + 32 : t0; const bf16_t* pr = proj + (size_t)(b * SEQ + tn0 + tq * 8) * INC + hd * 128 + d;
#pragma unroll
          for (int i = 0; i < 8; ++i) { rq[i] = pr[(size_t)i * INC + 512]; rf[i] = pr[(size_t)i * INC + 1024]; rv[i] = pr[(size_t)i * INC + 1536]; } }
        __syncthreads();
        {   const float t0v = tot[d], t1v = tot[128 + d], t2v = tot[256 + d], t3v = tot[384 + d];
            const float ref1 = t0v + t1v, blast = ref1 + t2v + t3v, off = (tq > 0 ? t0v : 0.f) + (tq > 1 ? t1v : 0.f) + (tq > 2 ? t2v : 0.f);
            unsigned ktw[4];
#pragma unroll
            for (int i = 0; i < 8; ++i) { const int t = tq * 8 + i; const float bt = off + cs[i];
                bF[t * 128 + d] = fd[i]; qsB[t * 128 + d] = f2bf(qs[i]); kkB[t * 128 + d] = f2bf(kk[i]);
                QH[t * 136 + d] = f2bf(qs[i] * __expf(bt));
                const float kt = kk[i] * __expf(blast - bt);
                if (i & 1) ktw[i >> 1] = cvt_pk_bf16(__uint_as_float(ktw[i >> 1]), kt); else ktw[i >> 1] = __float_as_uint(kt);
                if (tq >= 2) Q1[(t - 16) * 136 + d] = f2bf(qs[i] * __expf(bt - ref1)); else K0[t * 136 + d] = f2bf(kk[i] * __expf(ref1 - bt)); }
            *(LAS u32x4*)(KT + d * 40 + tq * 8) = (u32x4){ktw[0], ktw[1], ktw[2], ktw[3]};
            *(LAS u32x4*)(VT + d * 40 + tq * 8) = (u32x4){vraw[0] | (vraw[1] << 16), vraw[2] | (vraw[3] << 16), vraw[4] | (vraw[5] << 16), vraw[6] | (vraw[7] << 16)}; }
        __syncthreads();
#pragma unroll 1
        for (int rr = 0; rr < 4; ++rr) { const int sb = rr >> 1, tl = (rr & 1) ? 15 - w : w, t = sb * 16 + tl;
            const float q0 = bf2f(qsB[t * 128 + ln]), q1 = bf2f(qsB[t * 128 + 64 + ln]);
            float v[16]; float e0 = 1.f, e1 = 1.f;
#pragma unroll
            for (int sl = 15; sl >= 0; --sl) { const int s2 = sb * 16 + sl;
                if (sl <= tl) { v[sl] = q0 * bf2f(kkB[s2 * 128 + ln]) * e0 + q1 * bf2f(kkB[s2 * 128 + 64 + ln]) * e1; e0 *= bF[s2 * 128 + ln]; e1 *= bF[s2 * 128 + 64 + ln]; }
                else v[sl] = 0.f; }
            const bool c5 = ln & 32, c4 = ln & 16, c3 = ln & 8, c2 = ln & 4;
            float v8[8], v4[4], v2[2], v1;
#pragma unroll
            for (int i = 0; i < 8; ++i) { const float snd = c5 ? v[i] : v[i + 8]; const float rcv = __shfl_xor(snd, 32); v8[i] = (c5 ? v[i + 8] : v[i]) + rcv; }
#pragma unroll
            for (int i = 0; i < 4; ++i) { const float snd = c4 ? v8[i] : v8[i + 4]; const float rcv = __shfl_xor(snd, 16); v4[i] = (c4 ? v8[i + 4] : v8[i]) + rcv; }
#pragma unroll
            for (int i = 0; i < 2; ++i) { const float snd = c3 ? v4[i] : v4[i + 2]; const float rcv = __shfl_xor(snd, 8); v2[i] = (c3 ? v4[i + 2] : v4[i]) + rcv; }
            { const float snd = c2 ? v2[0] : v2[1]; const float rcv = __shfl_xor(snd, 4); v1 = (c2 ? v2[1] : v2[0]) + rcv; }
            v1 += __shfl_xor(v1, 2); v1 += __shfl_xor(v1, 1);
            const int sl = ln >> 2;
            if ((ln & 3) == 0) AM[t * 40 + sb * 16 + sl] = f2bf(sl <= tl ? v1 : 0.f);
            else if ((ln & 3) == 1 && sb == 0) AM[t * 40 + 16 + sl] = (bf16_t)0; }
        if (w == 0) { f32x4 o10 = (f32x4){0.f, 0.f, 0.f, 0.f};
#pragma unroll
            for (int ks = 0; ks < 4; ++ks) { const bf16x8 a = *(const LAS bf16x8*)(Q1 + l15 * 136 + 32 * ks + 8 * lq), bb = *(const LAS bf16x8*)(K0 + l15 * 136 + 32 * ks + 8 * lq); o10 = __builtin_amdgcn_mfma_f32_16x16x32_bf16(a, bb, o10, 0, 0, 0); }
#pragma unroll
            for (int r = 0; r < 4; ++r) AM[(16 + 4 * lq + r) * 40 + l15] = f2bf(o10[r]); }
        __syncthreads();
        const int mt = w & 1, np = w >> 1;
        f32x4 ao[2];
#pragma unroll
        for (int nt = 0; nt < 2; ++nt) { ao[nt] = (f32x4){0.f, 0.f, 0.f, 0.f}; const int en = 16 * (2 * np + nt) + l15;
#pragma unroll
            for (int ks = 0; ks < 4; ++ks) { const bf16x8 a = *(const LAS bf16x8*)(QH + (16 * mt + l15) * 136 + 32 * ks + 8 * lq), bb = *(const LAS bf16x8*)(ST + en * 136 + 32 * ks + 8 * lq); ao[nt] = __builtin_amdgcn_mfma_f32_16x16x32_bf16(a, bb, ao[nt], 0, 0, 0); }
            const bf16x8 a2 = *(const LAS bf16x8*)(AM + (16 * mt + l15) * 40 + 8 * lq), b2 = *(const LAS bf16x8*)(VT + en * 40 + 8 * lq); ao[nt] = __builtin_amdgcn_mfma_f32_16x16x32_bf16(a2, b2, ao[nt], 0, 0, 0); }
        {   float dec[4];
#pragma unroll
            for (int r = 0; r < 4; ++r) { const int dd = 16 * w + 4 * lq + r; dec[r] = __expf(tot[dd] + tot[128 + dd] + tot[256 + dd] + tot[384 + dd]); }
            const bf16x8 a3 = *(const LAS bf16x8*)(KT + (16 * w + l15) * 40 + 8 * lq);
#pragma unroll
            for (int nt = 0; nt < 8; ++nt) { f32x4 c = accS[nt];
#pragma unroll
                for (int r = 0; r < 4; ++r) c[r] *= dec[r];
                const bf16x8 b3 = *(const LAS bf16x8*)(VT + (16 * nt + l15) * 40 + 8 * lq); accS[nt] = __builtin_amdgcn_mfma_f32_16x16x32_bf16(a3, b3, c, 0, 0, 0); } }
        __syncthreads();
#pragma unroll
        for (int nt = 0; nt < 8; ++nt)
#pragma unroll
            for (int r = 0; r < 4; ++r) ST[(16 * nt + l15) * 136 + 16 * w + 4 * lq + r] = f2bf(accS[nt][r]);
#pragma unroll
        for (int nt = 0; nt < 2; ++nt)
#pragma unroll
            for (int r = 0; r < 4; ++r) OS[(16 * mt + 4 * lq + r) * 132 + 16 * (2 * np + nt) + l15] = ao[nt][r];
        __syncthreads();
        {   const int t = F.tid >> 4, e0 = (F.tid & 15) * 8; float o[8]; float ss = 0.f;
#pragma unroll
            for (int j = 0; j < 8; ++j) { o[j] = OS[t * 132 + e0 + j]; ss += o[j] * o[j]; }
            ss += __shfl_xor(ss, 1); ss += __shfl_xor(ss, 2); ss += __shfl_xor(ss, 4); ss += __shfl_xor(ss, 8);
            const float rs = rsqrtf(ss * (1.0f / 128.0f) + EPS);
            const size_t row = (size_t)(b * SEQ + t0 + t);
            float r[8];
#pragma unroll
            for (int j = 0; j < 8; ++j) { const float gg = (j & 1) ? bfhi(gv[j >> 1]) : bflo(gv[j >> 1]); r[j] = o[j] * rs * gnv[j] * siluf_(gg); }
            *(u32x4*)(ycat + row * D + 512 + hd * 128 + e0) = (u32x4){cvt_pk_bf16(r[0], r[1]), cvt_pk_bf16(r[2], r[3]), cvt_pk_bf16(r[4], r[5]), cvt_pk_bf16(r[6], r[7])};
        }
    }
}
__device__ __forceinline__ void mix_sb(const Ctx& F, const Params& p, int it) {
    const int qb = 15 - (it >> 6), bh = it & 63, b = bh >> 2, hd = bh & 3;
    const bf16_t* proj = (const bf16_t*)(p.ws + WS_PROJ);
    bf16_t* ycat = (bf16_t*)(p.ws + WS_YCAT);
    constexpr int KP = 136, VP = 72, SP = 72;
    LAS bf16_t* Kt = (LAS bf16_t*)F.lds;
    LAS bf16_t* Vt = Kt + 64 * KP;
    LAS bf16_t* Ws = Vt + 128 * VP + F.wid * (3 * 16 * SP);
    const int ln = F.lane, l15 = ln & 15, lq = ln >> 4;
    const int trow0 = qb * 128 + F.wid * 16;
    bf16x8 qa[4];
    { const bf16_t* qp = proj + (size_t)(b * SEQ + trow0 + l15) * INC + 2560 + hd * 128 + 8 * lq;
#pragma unroll
      for (int ks = 0; ks < 4; ++ks) qa[ks] = *(const bf16x8*)(qp + 32 * ks); }
    bf16x8 uA, uB, uOne;
#pragma unroll
    for (int j = 0; j < 8; ++j) { const int kk = 8 * lq + j; uA[j] = (kk > l15) ? (short)0x3F80 : (short)0; uB[j] = (kk > 16 + l15) ? (short)0x3F80 : (short)0; uOne[j] = (short)0x3F80; }
    f32x4 O[8];
#pragma unroll
    for (int nt = 0; nt < 8; ++nt) O[nt] = (f32x4){0.f, 0.f, 0.f, 0.f};
    float run[4] = {0.f, 0.f, 0.f, 0.f};
    for (int kt = qb * 2 + 1; kt >= 0; --kt) {
        __syncthreads();
#pragma unroll
        for (int c2 = 0; c2 < 2; ++c2) { const int c = F.tid + 512 * c2, row = c >> 4, c8 = (c & 15) * 8; const size_t rb = (size_t)(b * SEQ + kt * 64 + row) * INC + hd * 128 + c8;
            const u32x4 kw = *(const u32x4*)(proj + rb + 3072), vw = *(const u32x4*)(proj + rb + 3584);
            *(LAS u32x4*)(Kt + row * KP + c8) = kw;
#pragma unroll
            for (int j = 0; j < 4; ++j) { Vt[(c8 + 2 * j) * VP + row] = (bf16_t)(vw[j] & 0xffffu); Vt[(c8 + 2 * j + 1) * VP + row] = (bf16_t)(vw[j] >> 16); } }
        __syncthreads();
        f32x4 z[4];
#pragma unroll
        for (int nt = 0; nt < 4; ++nt) { z[nt] = (f32x4){0.f, 0.f, 0.f, 0.f};
#pragma unroll
            for (int ks = 0; ks < 4; ++ks) { const bf16x8 kf = *(const LAS bf16x8*)(Kt + (16 * nt + l15) * KP + 32 * ks + 8 * lq); z[nt] = __builtin_amdgcn_mfma_f32_16x16x32_bf16(qa[ks], kf, z[nt], 0, 0, 0); } }
        float lbv[4][4]; bool vld[4][4];
#pragma unroll
        for (int nt = 0; nt < 4; ++nt)
#pragma unroll
            for (int r = 0; r < 4; ++r) { const float zz = z[nt][r] * 0.08838834764831845f; const float sp = fmaxf(zz, 0.f) + __logf(1.0f + __expf(-fabsf(zz)));
                const bool valid = (kt * 64 + 16 * nt + l15) < (trow0 + 4 * lq + r); vld[nt][r] = valid; lbv[nt][r] = zz - sp;
                const float lnv = valid ? -sp : 0.f; const unsigned hi = cvt_pk_bf16(lnv, 0.f) & 0xffffu; const float lo = lnv - __uint_as_float(hi << 16);
                Ws[(4 * lq + r) * SP + 16 * nt + l15] = (bf16_t)hi; Ws[(16 + 4 * lq + r) * SP + 16 * nt + l15] = f2bf(lo); }
        __syncthreads();
        bf16x8 ah[2], al[2];
#pragma unroll
        for (int ks = 0; ks < 2; ++ks) { ah[ks] = *(const LAS bf16x8*)(Ws + l15 * SP + 32 * ks + 8 * lq); al[ks] = *(const LAS bf16x8*)(Ws + (16 + l15) * SP + 32 * ks + 8 * lq); }
        f32x4 sfx[4], tot = (f32x4){0.f, 0.f, 0.f, 0.f};
#pragma unroll
        for (int nt = 0; nt < 4; ++nt) sfx[nt] = (f32x4){0.f, 0.f, 0.f, 0.f};
        sfx[0] = __builtin_amdgcn_mfma_f32_16x16x32_bf16(ah[0], uA, sfx[0], 0, 0, 0);   sfx[0] = __builtin_amdgcn_mfma_f32_16x16x32_bf16(al[0], uA, sfx[0], 0, 0, 0);
        sfx[1] = __builtin_amdgcn_mfma_f32_16x16x32_bf16(ah[0], uB, sfx[1], 0, 0, 0);   sfx[1] = __builtin_amdgcn_mfma_f32_16x16x32_bf16(al[0], uB, sfx[1], 0, 0, 0);
        sfx[0] = __builtin_amdgcn_mfma_f32_16x16x32_bf16(ah[1], uOne, sfx[0], 0, 0, 0); sfx[0] = __builtin_amdgcn_mfma_f32_16x16x32_bf16(al[1], uOne, sfx[0], 0, 0, 0);
        sfx[1] = __builtin_amdgcn_mfma_f32_16x16x32_bf16(ah[1], uOne, sfx[1], 0, 0, 0); sfx[1] = __builtin_amdgcn_mfma_f32_16x16x32_bf16(al[1], uOne, sfx[1], 0, 0, 0);
        sfx[2] = __builtin_amdgcn_mfma_f32_16x16x32_bf16(ah[1], uA, sfx[2], 0, 0, 0);   sfx[2] = __builtin_amdgcn_mfma_f32_16x16x32_bf16(al[1], uA, sfx[2], 0, 0, 0);
        sfx[3] = __builtin_amdgcn_mfma_f32_16x16x32_bf16(ah[1], uB, sfx[3], 0, 0, 0);   sfx[3] = __builtin_amdgcn_mfma_f32_16x16x32_bf16(al[1], uB, sfx[3], 0, 0, 0);
#pragma unroll
        for (int ks = 0; ks < 2; ++ks) { tot = __builtin_amdgcn_mfma_f32_16x16x32_bf16(ah[ks], uOne, tot, 0, 0, 0); tot = __builtin_amdgcn_mfma_f32_16x16x32_bf16(al[ks], uOne, tot, 0, 0, 0); }
#pragma unroll
        for (int nt = 0; nt < 4; ++nt)
#pragma unroll
            for (int r = 0; r < 4; ++r) { const float w = vld[nt][r] ? __expf(lbv[nt][r] + sfx[nt][r] + run[r]) : 0.f; Ws[(32 + 4 * lq + r) * SP + 16 * nt + l15] = f2bf(w); }
#pragma unroll
        for (int r = 0; r < 4; ++r) run[r] += tot[r];
        __syncthreads();
        bf16x8 wf[2];
#pragma unroll
        for (int ks = 0; ks < 2; ++ks) wf[ks] = *(const LAS bf16x8*)(Ws + (32 + l15) * SP + 32 * ks + 8 * lq);
#pragma unroll
        for (int nt = 0; nt < 8; ++nt)
#pragma unroll
            for (int ks = 0; ks < 2; ++ks) { const bf16x8 vf = *(const LAS bf16x8*)(Vt + (16 * nt + l15) * VP + 32 * ks + 8 * lq); O[nt] = __builtin_amdgcn_mfma_f32_16x16x32_bf16(wf[ks], vf, O[nt], 0, 0, 0); }
        {   const bool live = !(run[0] < -110.0f && run[1] < -110.0f && run[2] < -110.0f && run[3] < -110.0f);
            __syncthreads();
            if (F.tid == 0) F.misc[9] = 0u;
            __syncthreads();
            if (live) F.misc[9] = 1u;
            __syncthreads();
            if (F.misc[9] == 0u) break;
        }
    }
#pragma unroll
    for (int nt = 0; nt < 8; ++nt)
#pragma unroll
        for (int r = 0; r < 4; ++r) ycat[(size_t)(b * SEQ + trow0 + 4 * lq + r) * D + 1024 + hd * 128 + 16 * nt + l15] = f2bf(O[nt][r]);
}
__device__ __forceinline__ void mix_s5(const Ctx& F, const Params& p, int l, int it) {
    const int b = it >> 5, g = it & 31, w = F.wid, ln = F.lane, l15 = ln & 15, lq = ln >> 4;
    const bf16_t* proj = (const bf16_t*)(p.ws + WS_PROJ);
    bf16_t* yg = (bf16_t*)(p.ws + WS_YG);
    constexpr int BP = 132, XP = 136;
    LAS float* bu = (LAS float*)(F.lds + w * (16 * BP * 4 + 16 * XP * 2));
    LAS bf16_t* xs = (LAS bf16_t*)((LAS unsigned char*)bu + 16 * BP * 4);
    LAS float* ends = (LAS float*)(F.lds + MISC_OFF + 256);
    const float* sp = (const float*)(p.ws + WS_S5P) + (size_t)((l * 32 + g) * 64) * 36;
    const float are = sp[ln * 36], aim = sp[ln * 36 + 1];
    bf16x8 bfr[8];
#pragma unroll
    for (int nt = 0; nt < 8; ++nt) { const int col = 16 * nt + l15, pp = col & 63; const float* q = sp + pp * 36 + ((col >> 6) ? 20 : 4) + 8 * lq;
#pragma unroll
        for (int j = 0; j < 8; ++j) bfr[nt][j] = (lq < 2) ? (short)f2bf(q[j]) : (short)0; }
    bf16x8 cfr[4];
#pragma unroll
    for (int ks = 0; ks < 4; ++ks) { const int k0 = 32 * ks + 8 * lq; const float* cp = ((ks < 2) ? p.c_re : p.c_im) + (((size_t)l * 32 + g) * 16 + l15) * 64 + (k0 & 63);
#pragma unroll
        for (int j = 0; j < 8; ++j) cfr[ks][j] = (short)f2bf((ks < 2) ? cp[j] : -cp[j]); }
    const float dsk = p.s5_d[l * BW + g * 16 + l15];
    const bf16_t* ubase = proj + (size_t)(b * SEQ + w * 256) * INC + g * 16;
    float xr = 0.f, xi = 0.f;
    __syncthreads();
    const u32x4 zero4 = (u32x4){0u, 0u, 0u, 0u};
    u32x4 un = *(const u32x4*)(ubase + (size_t)l15 * INC + 8 * lq);
    for (int tb = 0; tb < 16; ++tb) {
        const bf16x8 ua = __builtin_bit_cast(bf16x8, (lq < 2) ? un : zero4);
        { const int tn = tb < 15 ? tb + 1 : 15; un = *(const u32x4*)(ubase + (size_t)(tn * 16 + l15) * INC + 8 * lq); }
#pragma unroll
        for (int nt = 0; nt < 8; ++nt) { f32x4 d = __builtin_amdgcn_mfma_f32_16x16x32_bf16(ua, bfr[nt], (f32x4){0.f, 0.f, 0.f, 0.f}, 0, 0, 0);
#pragma unroll
            for (int r = 0; r < 4; ++r) bu[(4 * lq + r) * BP + 16 * nt + l15] = d[r]; }
        __syncthreads();
#pragma unroll
        for (int t = 0; t < 16; ++t) { const float br = bu[t * BP + ln], bi = bu[t * BP + 64 + ln]; const float nr = are * xr - aim * xi + br, ni = are * xi + aim * xr + bi; xr = nr; xi = ni; }
    }
    ends[(w * 64 + ln) * 2] = xr; ends[(w * 64 + ln) * 2 + 1] = xi;
    float pr = are, pi = aim;
#pragma unroll
    for (int i = 0; i < 8; ++i) { const float nr = pr * pr - pi * pi, ni = 2.0f * pr * pi; pr = nr; pi = ni; }
    __syncthreads();
    xr = 0.f; xi = 0.f;
    for (int ww = 0; ww < w; ++ww) { const float er = ends[(ww * 64 + ln) * 2], ei = ends[(ww * 64 + ln) * 2 + 1]; const float nr = pr * xr - pi * xi + er, ni = pr * xi + pi * xr + ei; xr = nr; xi = ni; }
    un = *(const u32x4*)(ubase + (size_t)l15 * INC + 8 * lq);
    for (int tb = 0; tb < 16; ++tb) {
        const bf16x8 ua = __builtin_bit_cast(bf16x8, (lq < 2) ? un : zero4);
        { const int tn = tb < 15 ? tb + 1 : 15; un = *(const u32x4*)(ubase + (size_t)(tn * 16 + l15) * INC + 8 * lq); }
        bf16_t uq[4];
#pragma unroll
        for (int r = 0; r < 4; ++r) uq[r] = proj[(size_t)(b * SEQ + w * 256 + tb * 16 + 4 * lq + r) * INC + g * 16 + l15];
#pragma unroll
        for (int nt = 0; nt < 8; ++nt) { f32x4 d = __builtin_amdgcn_mfma_f32_16x16x32_bf16(ua, bfr[nt], (f32x4){0.f, 0.f, 0.f, 0.f}, 0, 0, 0);
#pragma unroll
            for (int r = 0; r < 4; ++r) bu[(4 * lq + r) * BP + 16 * nt + l15] = d[r]; }
        __syncthreads();
#pragma unroll
        for (int t = 0; t < 16; ++t) { const float br = bu[t * BP + ln], bi = bu[t * BP + 64 + ln]; const float nr = are * xr - aim * xi + br, ni = are * xi + aim * xr + bi; xr = nr; xi = ni;
            xs[t * XP + ln] = f2bf(xr); xs[t * XP + 64 + ln] = f2bf(xi); }
        __syncthreads();
        f32x4 y = (f32x4){0.f, 0.f, 0.f, 0.f};
#pragma unroll
        for (int ks = 0; ks < 4; ++ks) { const bf16x8 xa = *(const LAS bf16x8*)(xs + l15 * XP + 32 * ks + 8 * lq); y = __builtin_amdgcn_mfma_f32_16x16x32_bf16(xa, cfr[ks], y, 0, 0, 0); }
#pragma unroll
        for (int r = 0; r < 4; ++r) { const size_t row = (size_t)(b * SEQ + w * 256 + tb * 16 + 4 * lq + r); const float uu = bf2f(uq[r]);
            yg[row * BW + g * 16 + l15] = f2bf(gelu_erf(y[r] + dsk * uu)); }
    }
}
__device__ __forceinline__ void mix_pool(const Ctx& F, const Params& p, int it) {
    const int b = it >> 5, t0 = (it & 31) * 64, ch = F.tid, win = 2 << (ch >> 7);
    const bf16_t* pp = (const bf16_t*)(p.ws + WS_PROJ) + (size_t)b * SEQ * INC + 4096;
    bf16_t* po = (bf16_t*)(p.ws + WS_POOLED) + (size_t)b * SEQ * BW + ch;
    LAS bf16_t* ps = (LAS bf16_t*)F.lds;
    for (int i = F.tid; i < 79 * 64; i += 512) { const int r = i >> 6, c8 = (i & 63) * 8, t = t0 - 15 + r;
        u32x4 v = (u32x4){0u, 0u, 0u, 0u};
        if (t >= 0) v = *(const u32x4*)(pp + (size_t)t * INC + c8);
        *(LAS u32x4*)(ps + r * 512 + c8) = v; }
    __syncthreads();
    for (int tt = 0; tt < 64; ++tt) { const int t = t0 + tt; float s = 0.f;
        for (int j = 0; j < win; ++j) s += bf2f(ps[(tt + 15 - j) * 512 + ch]);
        const float cur = bf2f(ps[(tt + 15) * 512 + ch]); const int cnt = (t + 1) < win ? (t + 1) : win;
        po[(size_t)t * BW] = f2bf(s * __builtin_amdgcn_rcpf((float)cnt) - cur); }
}
constexpr int MIX_HG = 64, MIX_SB = 1024, MIX_S5 = 512, MIX_POOL = 512;
__device__ __forceinline__ void phase_mixers_long(const Ctx& F, const Params& p, int l) {
    for (int it = blockIdx.x; it < MIX_HG; it += F.G) mix_hgrn2(F, p, l, it);
}
__device__ __forceinline__ void phase_mixers_short(const Ctx& F, const Params& p, int l) {
    for (;;) {
        int it = next_item(F, 1 + l);
        if (it >= MIX_SB + MIX_S5 + MIX_POOL) break;
        if (it < MIX_SB) mix_sb(F, p, it);
        else if ((it -= MIX_SB) < MIX_S5) mix_s5(F, p, l, it);
        else mix_pool(F, p, it - MIX_S5);
    }
}

__device__ __forceinline__ unsigned sort_key(float v, unsigned tag, unsigned mask) { const unsigned u = __float_as_uint(v); const unsigned s = u ^ ((u >> 31) ? 0xffffffffu : 0x80000000u); return (s & ~mask) | tag; }
__device__ __forceinline__ float key_val(unsigned k, unsigned mask) { const unsigned s = (k & ~mask) | (mask >> 1); const unsigned u = s ^ ((s >> 31) ? 0x80000000u : 0xffffffffu); return __uint_as_float(u); }
__device__ __forceinline__ void key_insert(unsigned (&val)[16], unsigned cv) {
#pragma unroll
    for (int j = 0; j < 16; ++j) { const unsigned hi = max(val[j], cv), lo = min(val[j], cv); val[j] = hi; cv = lo; }
}
__device__ __forceinline__ unsigned dppq_xor1(unsigned x) { return (unsigned)__builtin_amdgcn_update_dpp(0, (int)x, 0xB1, 0xf, 0xf, true); }
__device__ __forceinline__ unsigned dppq_xor2(unsigned x) { return (unsigned)__builtin_amdgcn_update_dpp(0, (int)x, 0x4E, 0xf, 0xf, true); }
#define KCE(a, b) do { const unsigned hi_ = max(a, b), lo_ = min(a, b); a = hi_; b = lo_; } while (0)
__device__ __forceinline__ void bitonic_merge16(unsigned (&v)[16]) {
#pragma unroll
    for (int j = 8; j >= 1; j >>= 1)
#pragma unroll
        for (int i = 0; i < 16; ++i) if ((i & j) == 0) KCE(v[i], v[i | j]);
}
__device__ __forceinline__ void bitonic_sort16(unsigned (&v)[16]) {
#pragma unroll
    for (int k = 2; k <= 16; k <<= 1)
#pragma unroll
        for (int j = k >> 1; j >= 1; j >>= 1)
#pragma unroll
            for (int i = 0; i < 16; ++i) if ((i & j) == 0) { if ((i & k) == 0 || k == 16) KCE(v[i], v[i | j]); else KCE(v[i | j], v[i]); }
}
__device__ __forceinline__ void top16_merge(unsigned (&a)[16], const unsigned (&b)[16]) {
#pragma unroll
    for (int i = 0; i < 16; ++i) a[i] = max(a[i], b[15 - i]);
    bitonic_merge16(a);
}
__device__ __forceinline__ void phase_topk(const Ctx& F, const Params& p) {
    const bf16_t* scores = (const bf16_t*)(p.ws + WS_G8);
    int* eidx = (int*)(p.ws + WS_EIDX); float* gate = (float*)(p.ws + WS_GATE);
    LAS bf16_t* sc = (LAS bf16_t*)F.lds;
    const int part = F.tid & 1, half = (F.tid >> 1) & 1, hd = (F.tid >> 2) & 7, tl = F.tid >> 5;
    for (int it8 = blockIdx.x * 8; it8 < M / 16; it8 += F.G * 8)
#pragma unroll 1
    for (int it4 = it8; it4 < it8 + 8; it4 += 4) {
      unsigned s0[16], s1[16];
#pragma unroll
      for (int j = 0; j < 16; ++j) { s0[j] = 0u; s1[j] = 0u; }
#pragma unroll 1
      for (int sub = 0; sub < 4; ++sub) { const int it = it4 + sub;
        __syncthreads();
        { const u32x4* src = (const u32x4*)(scores + (size_t)it * 16 * D); LAS u32x4* dst = (LAS u32x4*)sc;
#pragma unroll
          for (int i = 0; i < 8; ++i) dst[i * 512 + F.tid] = __builtin_nontemporal_load(src + i * 512 + F.tid); }
        __syncthreads();
        unsigned k0[16];
        const LAS bf16_t* row = sc + tl * D + hd * 256 + half * 128 + part * 64;
        {
            unsigned ga[16], gb[16];
#pragma unroll
            for (int i = 0; i < 16; ++i) { const int idx = (i + F.tid) & 63; k0[i] = sort_key(bf2f(row[idx]), 127u - (unsigned)(part * 64 + idx), 127u); }
#pragma unroll
            for (int i = 0; i < 16; ++i) { const int idx = (16 + i + F.tid) & 63; ga[i] = sort_key(bf2f(row[idx]), 127u - (unsigned)(part * 64 + idx), 127u); }
            bitonic_sort16(k0); bitonic_sort16(ga); top16_merge(k0, ga);
#pragma unroll
            for (int i = 0; i < 16; ++i) { const int idx = (32 + i + F.tid) & 63; ga[i] = sort_key(bf2f(row[idx]), 127u - (unsigned)(part * 64 + idx), 127u); }
#pragma unroll
            for (int i = 0; i < 16; ++i) { const int idx = (48 + i + F.tid) & 63; gb[i] = sort_key(bf2f(row[idx]), 127u - (unsigned)(part * 64 + idx), 127u); }
            bitonic_sort16(ga); bitonic_sort16(gb); top16_merge(ga, gb); top16_merge(k0, ga);
        }
        { unsigned o[16];
#pragma unroll
          for (int j = 0; j < 16; ++j) o[j] = dppq_xor1(k0[j]);
          top16_merge(k0, o); }
        { const bool mine = (F.tid & 3) == sub;
#pragma unroll
          for (int j = 0; j < 16; ++j) { const unsigned k1 = dppq_xor2(k0[j]); const unsigned h0 = half ? k1 : k0[j], h1 = half ? k0[j] : k1;
              s0[j] = mine ? h0 : s0[j]; s1[j] = mine ? h1 : s1[j]; } }
      }
        __syncthreads();
        {   const int it = it4 + (F.tid & 3);
            LAS unsigned* kl = (LAS unsigned*)F.lds + F.tid * 33;
            float v0[16], v1[16];
#pragma unroll
            for (int j = 0; j < 16; ++j) { v0[j] = key_val(s0[j], 127u); v1[j] = key_val(s1[j], 127u); kl[j] = 127u - (s0[j] & 127u); kl[16 + j] = 127u - (s1[j] & 127u); }
            unsigned bk[16], ga[16], gb[16];
            {   int n = 0;
#pragma unroll
                for (int i = 0; i < 16; ++i)
#pragma unroll
                    for (int j = 0; j < 16; ++j) if ((i + 1) * (j + 1) <= 16) { const unsigned kv = sort_key(v0[i] + v1[j], 255u - (unsigned)(i * 16 + j), 255u);
                        if (n < 16) bk[n] = kv; else if (n < 32) ga[n - 16] = kv; else if (n < 48) gb[n - 32] = kv; ++n; }
            }
            bitonic_sort16(bk); bitonic_sort16(ga); top16_merge(bk, ga);
            {
                int n = 0;
#pragma unroll
                for (int q = 0; q < 16; ++q) ga[q] = 0u;
#pragma unroll
                for (int i = 0; i < 16; ++i)
#pragma unroll
                    for (int j = 0; j < 16; ++j) if ((i + 1) * (j + 1) <= 16) { if (n >= 48) ga[n - 48] = sort_key(v0[i] + v1[j], 255u - (unsigned)(i * 16 + j), 255u); ++n; }
            }
            bitonic_sort16(gb); bitonic_sort16(ga); top16_merge(gb, ga); top16_merge(bk, gb);
            float ex[16], sum = 0.f; const float top = key_val(bk[0], 255u);
#pragma unroll
            for (int j = 0; j < 16; ++j) { ex[j] = __expf(key_val(bk[j], 255u) - top); sum += ex[j]; }
            const float inv = 1.0f / sum;
            int bi[16];
#pragma unroll
            for (int j = 0; j < 16; ++j) { const unsigned pr = 255u - (bk[j] & 255u); bi[j] = (int)(kl[pr >> 4] * 128u + kl[16 + (pr & 15u)]); }
            const int t = it * 16 + tl;
            int* ep = eidx + (size_t)t * 128 + hd * 16; float* gp = gate + (size_t)t * 128 + hd * 16;
#pragma unroll
            for (int j = 0; j < 16; j += 4) { *(int4*)(ep + j) = make_int4(bi[j], bi[j + 1], bi[j + 2], bi[j + 3]); *(f32x4*)(gp + j) = (f32x4){ex[j] * inv, ex[j + 1] * inv, ex[j + 2] * inv, ex[j + 3] * inv}; }
        }
    }
}
__device__ __forceinline__ float dot16_fp8(const f32x2 (&h2)[8], const u32x4 r) {
    f32x2 z = (f32x2){0.f, 0.f};
#pragma unroll
    for (int w = 0; w < 4; ++w) { const f32x2 lo = __builtin_amdgcn_cvt_pk_f32_fp8((int)r[w], false), hi = __builtin_amdgcn_cvt_pk_f32_fp8((int)r[w], true);
        z = __builtin_elementwise_fma(h2[2 * w], lo, z); z = __builtin_elementwise_fma(h2[2 * w + 1], hi, z); }
    return z[0] + z[1];
}
#define PEER_GATHER(dst, esrc) do { _Pragma("unroll") for (int ii = 0; ii < 8; ++ii) { const int e_ = __shfl((esrc), 8 * ii + g); dst[ii] = *(const u32x4*)(T8 + (unsigned)(e_ * 128 + j * 16)); } } while (0)
__device__ __forceinline__ void peer_v_accum(const u32x4 (&r)[8], float wsrc, f32x2 (&ac2)[8], int g) {
#pragma unroll
    for (int ii = 0; ii < 8; ++ii) { const float wv = __shfl(wsrc, 8 * ii + g); const f32x2 ws2 = (f32x2){wv, wv};
#pragma unroll
        for (int w = 0; w < 4; ++w) { const f32x2 lo = __builtin_amdgcn_cvt_pk_f32_fp8((int)r[ii][w], false), hi = __builtin_amdgcn_cvt_pk_f32_fp8((int)r[ii][w], true);
            ac2[2 * w] = __builtin_elementwise_fma(ws2, lo, ac2[2 * w]); ac2[2 * w + 1] = __builtin_elementwise_fma(ws2, hi, ac2[2 * w + 1]); } }
}
__device__ __forceinline__ void peer_u_accum_lds(const u32x4 (&r)[8], const f32x2 (&h)[8], LAS float* zrow, int half, int g, int j, bool b0, bool b1, bool b2) {
    float pz[8];
#pragma unroll
    for (int ii = 0; ii < 8; ++ii) pz[ii] = dot16_fp8(h, r[ii]);
    float q4[4], q2[2];
#pragma unroll
    for (int i = 0; i < 4; ++i) { const float snd = b2 ? pz[i] : pz[i + 4]; const float rcv = __shfl_xor(snd, 4); q4[i] = (b2 ? pz[i + 4] : pz[i]) + rcv; }
#pragma unroll
    for (int i = 0; i < 2; ++i) { const float snd = b1 ? q4[i] : q4[i + 2]; const float rcv = __shfl_xor(snd, 2); q2[i] = (b1 ? q4[i + 2] : q4[i]) + rcv; }
    const float snd = b0 ? q2[0] : q2[1]; const float rcv = __shfl_xor(snd, 1); const float q1 = (b0 ? q2[1] : q2[0]) + rcv;
    zrow[8 * (half * 8 + j) + g] += q1;
}
__device__ __forceinline__ void phase_peer_fused(const Ctx& F, const Params& p, int l, float* xres) {
    const bf16_t* H = (const bf16_t*)(p.ws + WS_H);
    const int* eidx = (const int*)(p.ws + WS_EIDX); const float* gate = (const float*)(p.ws + WS_GATE);
    const float* su = (const float*)(p.ws + WS_SU) + l * NEXP; const float* sv = (const float*)(p.ws + WS_SV) + l * NEXP;
    const float* g2 = (const float*)(p.ws + WS_MOD) + (size_t)l * BATCH * ADA + 5 * D;
    const int g = F.lane >> 3, j = F.lane & 7; const bool b0 = F.lane & 1, b1 = F.lane & 2, b2 = F.lane & 4, b3 = F.lane & 8, b4 = F.lane & 16, b5 = F.lane & 32;
    LAS float* zl = (LAS float*)F.lds + F.wid * (16 * 128);
    for (int tile = blockIdx.x; tile < M / 128; tile += F.G) {
        const int t0 = tile * 128 + F.wid * 16, b = t0 / SEQ;
#pragma unroll
        for (int i = 0; i < 32; ++i) zl[i * 64 + F.lane] = 0.f;
        {   const unsigned char* T8b = p.ws + WS_PU8 + (size_t)l * 16 * NEXP * 128;
            const unsigned jo = (unsigned)(j * 16), lo_ = (unsigned)F.lane;
            u32x4 hw0 = *(const u32x4*)(H + (size_t)t0 * D + jo), hw1 = *(const u32x4*)(H + (size_t)t0 * D + 8 + jo); int e_a = (eidx + (size_t)t0 * 128)[lo_], e_b = (eidx + (size_t)t0 * 128 + 64)[lo_];
            u32x4 ra[8], rb[8];
            { const unsigned char* T8 = T8b; PEER_GATHER(ra, e_a); }
#pragma unroll 1
            for (int st = 0; st < 256; ++st) {
                const int s = st >> 4, tk = st & 15, sx = st < 255 ? st + 1 : st, sn = sx >> 4, tn = sx & 15;
                const bf16_t* hn = H + ((size_t)(t0 + tn) * D + sn * 128);
                const u32x4 nw0 = __builtin_nontemporal_load((const u32x4*)(hn + jo)), nw1 = __builtin_nontemporal_load((const u32x4*)(hn + 8 + jo)); const int* en = eidx + (size_t)(t0 + tn) * 128; const int ne_a = en[lo_], ne_b = (en + 64)[lo_];
                { const unsigned char* T8 = T8b + (size_t)s * NEXP * 128; PEER_GATHER(rb, e_b); }
                f32x2 h[8];
#pragma unroll
                for (int q = 0; q < 4; ++q) { h[q] = (f32x2){bflo(hw0[q]), bfhi(hw0[q])}; h[4 + q] = (f32x2){bflo(hw1[q]), bfhi(hw1[q])}; }
                peer_u_accum_lds(ra, h, zl + tk * 128, 0, g, j, b0, b1, b2);
                { const unsigned char* T8 = T8b + (size_t)sn * NEXP * 128; PEER_GATHER(ra, ne_a); }
                peer_u_accum_lds(rb, h, zl + tk * 128, 1, g, j, b0, b1, b2);
                hw0 = nw0; hw1 = nw1; e_a = ne_a; e_b = ne_b;
            }
        }
        __syncthreads();
#pragma unroll 4
        for (int tk = 0; tk < 16; ++tk) { const float rs = rsqrtf((float)((const unsigned long long*)(p.ws + WS_RSS))[t0 + tk] * (RSS_INV / D) + EPS);
#pragma unroll
            for (int hh = 0; hh < 2; ++hh) { const int k = hh * 64 + F.lane; const size_t gi = (size_t)(t0 + tk) * 128 + k; const int e = eidx[gi];
                zl[tk * 128 + k] = gate[gi] * gelu_erf((zl[tk * 128 + k] * rs + ((const float*)(p.ws + WS_SD))[(size_t)b * NEXP + e]) * su[e]) * sv[e]; } }
        __syncthreads();
        {   const unsigned char* T8b = p.ws + WS_PV8 + (size_t)l * 16 * NEXP * 128;
            const unsigned colj = (unsigned)(j * 16 + (b3 ? 8 : 0) + (b4 ? 4 : 0) + (b5 ? 2 : 0)), lo_ = (unsigned)F.lane;
            int e_a = (eidx + (size_t)t0 * 128)[lo_], e_b = (eidx + (size_t)t0 * 128 + 64)[lo_];
            u32x4 ra[8], rb[8];
            { const unsigned char* T8 = T8b; PEER_GATHER(ra, e_a); }
#pragma unroll 1
            for (int st = 0; st < 256; ++st) {
                const int s = st >> 4, tk = st & 15, sx = st < 255 ? st + 1 : st, sn = sx >> 4, tn = sx & 15;
                const int* en = eidx + (size_t)(t0 + tn) * 128; const int ne_a = en[lo_], ne_b = (en + 64)[lo_];
                const float w_a = zl[tk * 128 + F.lane], w_b = zl[tk * 128 + 64 + F.lane];
                const f32x2 gv = *(const f32x2*)(g2 + ((size_t)b * ADA + s * 128) + colj);
                float* xp = xres + ((size_t)(t0 + tk) * D + s * 128) + colj; const f32x2 xv = __builtin_nontemporal_load((const f32x2*)xp);
                { const unsigned char* T8 = T8b + (size_t)s * NEXP * 128; PEER_GATHER(rb, e_b); }
                f32x2 ac2[8];
#pragma unroll
                for (int c = 0; c < 8; ++c) ac2[c] = (f32x2){0.f, 0.f};
                peer_v_accum(ra, w_a, ac2, g);
                { const unsigned char* T8 = T8b + (size_t)sn * NEXP * 128; PEER_GATHER(ra, ne_a); }
                peer_v_accum(rb, w_b, ac2, g);
                float acc[16];
#pragma unroll
                for (int c = 0; c < 8; ++c) { acc[2 * c] = ac2[c][0]; acc[2 * c + 1] = ac2[c][1]; }
                float a8[8], a4[4], a2[2];
#pragma unroll
                for (int i = 0; i < 8; ++i) { const float snd = b3 ? acc[i] : acc[i + 8]; const float rcv = __shfl_xor(snd, 8); a8[i] = (b3 ? acc[i + 8] : acc[i]) + rcv; }
#pragma unroll
                for (int i = 0; i < 4; ++i) { const float snd = b4 ? a8[i] : a8[i + 4]; const float rcv = __shfl_xor(snd, 16); a4[i] = (b4 ? a8[i + 4] : a8[i]) + rcv; }
#pragma unroll
                for (int i = 0; i < 2; ++i) { const float snd = b5 ? a4[i] : a4[i + 2]; const float rcv = __shfl_xor(snd, 32); a2[i] = (b5 ? a4[i + 2] : a4[i]) + rcv; }
                __builtin_nontemporal_store((f32x2){xv[0] + gv[0] * a2[0], xv[1] + gv[1] * a2[1]}, (f32x2*)xp);
                e_a = ne_a; e_b = ne_b;
            }
        }
        asm volatile("s_waitcnt vmcnt(0)" ::: "memory");
        __builtin_amdgcn_fence(__ATOMIC_ACQUIRE, "agent");
        asm volatile("s_waitcnt vmcnt(0)" ::: "memory");
        if (l + 1 < DEPTH) { const float* mod1 = (const float*)(p.ws + WS_MOD) + (size_t)(l + 1) * BATCH * ADA; const float* gn = p.nmg + (l + 1) * D;
            asm volatile("" : "+s"(mod1), "+s"(gn));
#pragma unroll 1
            for (int tk = 0; tk < 16; tk += 4) norm_rows<0, 4>(F, t0 + tk, xres, gn, mod1, mod1 + D, (bf16_t*)(p.ws + WS_H), nullptr);
        } else { const float* gn = p.final_gain;
            asm volatile("" : "+s"(gn));
#pragma unroll 1
            for (int tk = 0; tk < 16; tk += 4) norm_rows<1, 4>(F, t0 + tk, xres, gn, nullptr, nullptr, nullptr, xres);
        }
    }
}
constexpr int PH_PER_LAYER = 11, N_PHASES = 1 + DEPTH * PH_PER_LAYER;
typedef const __attribute__((address_space(4))) Params* KParamPtr;
#if defined(__HIP_DEVICE_COMPILE__)
#define PARAMS() ({ KParamPtr k_ = (KParamPtr)__builtin_amdgcn_kernarg_segment_ptr(); asm volatile("" : "+s"(k_)); *k_; })
#else
#define PARAMS() (Params{})
#endif
#define MAKE_CTX(Fn) Ctx Fn; { Fn.lds = (LAS unsigned char*)lds_raw; Fn.misc = (volatile LAS unsigned*)(Fn.lds + MISC_OFF); int t_ = threadIdx.x; asm volatile("" : "+v"(t_)); Fn.tid = t_; Fn.lane = t_ & 63; Fn.wid = __builtin_amdgcn_readfirstlane(t_ >> 6); Fn.G = gridDim.x; Fn.ctl = (unsigned*)(p.ws + WS_CTL); }
#define PHASE_ENV const Params p = PARAMS(); unsigned char* ws = p.ws; bf16_t* Hb = (bf16_t*)(ws + WS_H); bf16_t* PROJ = (bf16_t*)(ws + WS_PROJ); unsigned char* G8 = ws + WS_G8; const float* mod = (const float*)(ws + WS_MOD) + (size_t)l_ * BATCH * ADA; const float* xin = (l_ == 0) ? p.x : p.out; MAKE_CTX(F); (void)Hb; (void)PROJ; (void)G8; (void)mod; (void)xin; (void)F
#define IN(k) (lo <= (k) && (k) < hi)
#define SEAM(k) do { if (IN((k) + 1)) { const Params pq = PARAMS(); XcdBarrier bar; bar.bar = (unsigned*)(pq.ws + WS_CTL); bar.x = xb_xcc_id(); bar.st = (volatile LAS unsigned*)((LAS unsigned char*)lds_raw + MISC_OFF); xcd_barrier(bar); } } while (0)
template <int l>
__device__ __forceinline__ void layer_phases(const int lo, const int hi) {
    extern __shared__ __attribute__((aligned(16))) unsigned char lds_raw[];
        const int pb = 1 + l * PH_PER_LAYER;
        const int l_ = l;
        if (l == 0 && IN(pb + 0)) { PHASE_ENV; const Ctx& Fp = F; phase_norm<0>(Fp, xin, p.nmg + l * D, mod, mod + D, Hb, nullptr); SEAM(pb + 0); }
        if (IN(pb + 1)) { PHASE_ENV; pg8::Gemm g{Hb, (const bf16_t*)(ws + WS_BCAT) + (size_t)l * NCAT * D, M, INC, D, D, D, 0, 0, 0}; pg8::StaticOrder S; S.init(M, INC, F.G, (int)blockIdx.x);
            EpiBf16 E{PROJ, INC, 0}; pg8::gemm_phase(F.lds, g, S, E); SEAM(pb + 1); }
        if (IN(pb + 2)) { PHASE_ENV; const Ctx& Fp = F; phase_mixers_long(Fp, p, l);
            __syncthreads();
            { pg8::Gemm g{Hb, (const bf16_t*)(ws + WS_BCAT) + ((size_t)l * NCAT + INC) * D, M, 4 * D, D, D, D, 0, 0, 0};
              pg8::LateOrder S; S.init(M, 4 * D, F.G, (int)blockIdx.x); if (F.G == 256) { S.nhg = 64; S.r0 = 13; S.ex = 4; } else { S.nhg = 0; S.r0 = (S.nwg + F.G - 1) / F.G; S.ex = 0; }
              EpiGateT E{G8}; pg8::gemm_phase(F.lds, g, S, E); }
            __syncthreads();
            phase_mixers_short(Fp, p, l);
            SEAM(pb + 2); }
        if (IN(pb + 3)) { PHASE_ENV;
            { pg8::Gemm g{(const bf16_t*)(ws + WS_YG), (const bf16_t*)(ws + WS_WGLUT) + (size_t)l * BW * BW, M, BW, BW, BW, BW, 0, 0, 0}; pg8::StaticOrder S; S.init(M, BW, F.G, (int)blockIdx.x);
              EpiGlu E{(const bf16_t*)(ws + WS_YG), p.b_glu + l * BW, (bf16_t*)(ws + WS_YCAT)}; pg8::gemm_phase(F.lds, g, S, E); }
            { pg8::Gemm g{(const bf16_t*)(ws + WS_POOLED), (const bf16_t*)(ws + WS_POOLT) + (size_t)l * BW * BW, M, BW, BW, BW, BW, 0, 0, 0}; pg8::StaticOrder S; S.init(M, BW, F.G, (int)blockIdx.x);
              EpiBf16 E{(bf16_t*)(ws + WS_YCAT), D, 1536}; pg8::gemm_phase(F.lds, g, S, E); }
            { const Ctx& Fp = F; aux_shift_tables(Fp, p, l); }
            SEAM(pb + 3); }
        if (IN(pb + 4)) { PHASE_ENV;
            { pg8::Gemm g{(const bf16_t*)(ws + WS_YCAT), (const bf16_t*)(ws + WS_WBT) + (size_t)l * D * D, M, D, D, D, D, 0, 0, 0}; pg8::StaticOrder S; S.init(M, D, F.G, (int)blockIdx.x); EpiMerge E{G8, PROJ}; pg8::gemm_phase(F.lds, g, S, E); }
            SEAM(pb + 4); }
        if (IN(pb + 5)) { PHASE_ENV; pg8::Gemm g{PROJ, (const bf16_t*)(ws + WS_WOT) + (size_t)l * D * D, M, D, D, D, D, 0, 0, 0}; pg8::StaticOrder S; S.init(M, D, F.G, (int)blockIdx.x);
            EpiResidN E{xin, mod + 2 * D, p.out, p.nfg + l * D, mod + 4 * D, Hb, (unsigned long long*)(ws + WS_RSS)}; pg8::gemm_phase(F.lds, g, S, E); SEAM(pb + 6); }
        if (IN(pb + 7)) { PHASE_ENV; pg8::Gemm g{Hb, (const bf16_t*)(ws + WS_WQT) + (size_t)l * D * D, M, D, D, D, D, 0, 0, 0}; pg8::StaticOrder S; S.init(M, D, F.G, (int)blockIdx.x);
            EpiScore E{(bf16_t*)(ws + WS_G8), (const unsigned long long*)(ws + WS_RSS), (const float*)(ws + WS_C0)}; pg8::gemm_phase(F.lds, g, S, E); SEAM(pb + 8); }
        if (IN(pb + 9)) { PHASE_ENV; const Ctx& Fp = F; phase_topk(Fp, p);
            asm volatile("s_waitcnt vmcnt(0)" ::: "memory"); __syncthreads(); __builtin_amdgcn_fence(__ATOMIC_ACQUIRE, "agent"); }
        if (IN(pb + 10)) { PHASE_ENV; const Ctx& Fp = F; phase_peer_fused(Fp, p, l, p.out); SEAM(pb + 10); }
    }
__global__ void __launch_bounds__(512, 2) mega(Params p_unused) {
    extern __shared__ __attribute__((aligned(16))) unsigned char lds_raw[];
    {   volatile LAS unsigned* misc0 = (volatile LAS unsigned*)((LAS unsigned char*)lds_raw + MISC_OFF);
        if (threadIdx.x < 16) misc0[threadIdx.x] = 0u;
        __syncthreads();
        if (N_LAUNCHES == 1) { const Params p0 = PARAMS(); (void)xcd_barrier_post((unsigned*)(p0.ws + WS_CTL), misc0); } }
    int lo, hi; { const Params p0 = PARAMS(); lo = p0.ph_lo; hi = p0.ph_hi; }
    { const int l_ = 0; if (IN(0)) { PHASE_ENV; const Ctx& Fp = F; phase_prologue(Fp, p); SEAM(0); } }
    layer_phases<0>(lo, hi);
    layer_phases<1>(lo, hi);
#undef IN
#undef SEAM
#undef PHASE_ENV
}

extern "C" void kernel_launch(void* const* d_in, const int* in_sizes, int n_in, void* d_out, int out_size, void* d_ws, size_t ws_size, hipStream_t stream) {
    static int grid = 0;
    if (grid == 0) {
        if (n_in != 29 || ws_size < WS_END) { fprintf(stderr, "kernel_launch: need 29 inputs and %zu bytes of workspace; got %d, %zu\n", (size_t)WS_END, n_in, ws_size); grid = -1; return; }
        int dev = 0, cus = 0, per_cu = 0;
        if (hipGetDevice(&dev) != hipSuccess || hipDeviceGetAttribute(&cus, hipDeviceAttributeMultiprocessorCount, dev) != hipSuccess) { grid = -1; return; }
        if (hipFuncSetAttribute((const void*)mega, hipFuncAttributeMaxDynamicSharedMemorySize, LDS_BYTES) != hipSuccess) { fprintf(stderr, "kernel_launch: hipFuncSetAttribute failed\n"); grid = -1; return; }
        if (hipOccupancyMaxActiveBlocksPerMultiprocessor(&per_cu, (const void*)mega, 512, LDS_BYTES) != hipSuccess || per_cu < 1) { fprintf(stderr, "kernel_launch: occupancy query says %d\n", per_cu); }
        (void)hipGetLastError();
        grid = cus;
    }
    if (grid < 0) return;
    (void)hipMemsetAsync((char*)d_ws + WS_CTL, 0, CTL_BYTES, stream);
    Params p{};
    const float** pp = (const float**)&p;
    for (int i = 0; i < 29; ++i) pp[i] = (const float*)d_in[i];
    p.out = (float*)d_out; p.ws = (unsigned char*)d_ws;
#if N_LAUNCHES == 1
    p.ph_lo = 0; p.ph_hi = N_PHASES;
    hipLaunchKernelGGL(mega, dim3(grid), dim3(512), LDS_BYTES, stream, p);
#else
    for (int k = 0; k < N_PHASES; ++k) { p.ph_lo = k; p.ph_hi = k + 1; hipLaunchKernelGGL(mega, dim3(grid), dim3(512), LDS_BYTES, stream, p); }
#endif
}
```

```cpp
#include <hip/hip_runtime.h>
#include <cstdio>
#include <cstdint>

#ifndef N_LAUNCHES
#define N_LAUNCHES 1
#endif

#define LAS __attribute__((address_space(3)))
typedef unsigned short bf16_t;
typedef short bf16x8 __attribute__((ext_vector_type(8)));
typedef float f32x4 __attribute__((ext_vector_type(4)));
typedef float f32x2 __attribute__((ext_vector_type(2)));
typedef unsigned u32x4 __attribute__((ext_vector_type(4)));
typedef unsigned u32x2 __attribute__((ext_vector_type(2)));

constexpr int D = 2048, BATCH = 16, SEQ = 2048, M = BATCH * SEQ, DEPTH = 2;
constexpr int BW = 512, INC = 4608, NCAT = INC + 4 * D  , ADA = 6 * D;
constexpr int NEXP = 16384;
constexpr float EPS = 1e-6f;

__device__ __forceinline__ float bf2f(unsigned v) { return __uint_as_float(v << 16); }
__device__ __forceinline__ float bflo(unsigned w) { return __uint_as_float(w << 16); }
__device__ __forceinline__ float bfhi(unsigned w) { return __uint_as_float(w & 0xffff0000u); }
typedef __bf16 bf16x2_t __attribute__((ext_vector_type(2)));
__device__ __forceinline__ unsigned cvt_pk_bf16(float lo, float hi) { const bf16x2_t v = __builtin_convertvector((f32x2){lo, hi}, bf16x2_t); return __builtin_bit_cast(unsigned, v); }
__device__ __forceinline__ bf16_t f2bf(float f) { return (bf16_t)(cvt_pk_bf16(f, 0.f) & 0xffffu); }
__device__ __forceinline__ float sigmoidf_(float x) { return __builtin_amdgcn_rcpf(1.0f + __expf(-x)); }
__device__ __forceinline__ float siluf_(float x) { return x * __builtin_amdgcn_rcpf(1.0f + __expf(-x)); }
__device__ __forceinline__ float gelu_erf(float x) { return 0.5f * x * (1.0f + erff(x * 0.70710678118654752f)); }

#define WAVE_SYNC() asm volatile("s_waitcnt lgkmcnt(0)" ::: "memory")

#ifndef PG8_USE_SP2
#define PG8_USE_SP2 true
#endif
namespace pg8 {
constexpr int BM = 256, BK = 64, HALF = 128, HTB = HALF * BK * 2, STAGE_BYTES = 8 * HTB, NXCD = 8, WGM = 8;
__host__ __device__ __forceinline__ int lds_byte(int r, int c) { const int st = (r >> 4) * 2 + (c >> 5), rr = r & 15, cc = c & 31, ob = rr * 64 + cc * 2; return st * 1024 + (ob ^ (((ob >> 9) & 1) << 5)); }
__host__ __device__ __forceinline__ void stage_rc(int b, int& R, int& C) { const int st = b / 1024, sb = b % 1024, swz = sb ^ (((sb >> 9) & 1) << 5); R = (st >> 1) * 16 + swz / 64; C = (st & 1) * 32 + (swz % 64) / 2; }
__host__ __device__ __forceinline__ int perm32(int rho) { const int n = rho >> 4, i = rho & 15; return 8 * (i >> 2) + 4 * n + (i & 3); }
struct Unit { int pm, pn, pz; };
struct Gemm { const bf16_t* A; const bf16_t* Bt; int M, N, K, lda, ldb, apn; size_t zA, zB; };
struct StaticOrder {
    int nM, nN, nwg, G, c;
    __host__ __device__ void init(int M_, int N_, int G_, int c_) { nM = M_ / BM; nN = N_ / BM; nwg = nM * nN; G = G_; c = c_; }
    __host__ __device__ bool next(int i, Unit& u) const { return decode((long)i * G + c, u); }
    __host__ __device__ bool decode(long L, Unit& u) const {
        if (L >= nwg) return false;
        int wgid = (int)L; { const int q = nwg / NXCD, r = nwg % NXCD, xcd = wgid % NXCD, off = wgid / NXCD; wgid = (xcd < r ? xcd * (q + 1) : r * (q + 1) + (xcd - r) * q) + off; }
        const int nig = WGM * nN, gid = wgid / nig, fm = gid * WGM, gsz = (nM - fm) < WGM ? (nM - fm) : WGM;
        u.pm = fm + ((wgid % nig) % gsz); u.pn = (wgid % nig) / gsz; u.pz = 0; return true;
    }
    __device__ __forceinline__ void a_ready(const Unit&) const {}
    __device__ __forceinline__ void done(const Unit&) const {}
};
struct LateOrder : StaticOrder {
    int nhg, r0, ex;
    __host__ __device__ bool next(int i, Unit& u) const {
        if (i < r0) return decode((long)i * G + c, u);
        if (c < nhg || i >= r0 + ex) return false;
        return decode((long)r0 * G + (long)(i - r0) * (G - nhg) + (c - nhg), u);
    }
};
template <int NZ> struct ZInnerOrder : StaticOrder {
    __host__ __device__ bool next(int i, Unit& u) const { const bool ok = StaticOrder::next(i / NZ, u); u.pz = i % NZ; return ok; }
};
template <class Epi, class Sched, bool SP2 = PG8_USE_SP2>
__device__ __forceinline__ void gemm_phase(LAS unsigned char* lds, const Gemm g, const Sched& S, const Epi& E) {
    int tid_ = threadIdx.x; asm volatile("" : "+v"(tid_));
    const int tid = tid_, wid = __builtin_amdgcn_readfirstlane(tid >> 6), lane = tid & 63, wr = wid >> 2, wc = wid & 3, fr = lane & 15, fq = lane >> 4;
    const int K = g.K, nt = K / BK;
    unsigned voffA[2], voffB[2];
#pragma unroll
    for (int i = 0; i < 2; ++i) { int R, C; stage_rc(tid * 16 + i * 8192, R, C); const int Rb = Epi::PERM ? ((R & ~31) + perm32(R & 31)) : R;
        voffA[i] = (unsigned)(R * g.lda + C) * 2u; voffB[i] = (unsigned)(Rb * g.ldb + C) * 2u; }
    const size_t kstep = (size_t)(BK * 2);
    const size_t hstepA = (size_t)HALF * g.lda * 2, hstepB = (size_t)HALF * g.ldb * 2;
    const size_t tstepA = 2 * hstepA, tstepB = 2 * hstepB, pstepA = (size_t)g.apn * 2, zstepA = g.zA * 2, zstepB = g.zB * 2;
    const unsigned ldsw = (unsigned)wid * 1024u;
    const int aoff = lds_byte(wr * 64 + fr, fq * 8), boff = lds_byte(wc * 32 + fr, fq * 8);
#define PG8_SA(b, h) (((b) * 2 + (h)) * HTB)
#define PG8_SB(b, h) ((4 + (b) * 2 + (h)) * HTB)
#define PG8_STAGE(bufoff, gbase, voff) do { _Pragma("unroll") for (int _i = 0; _i < 2; ++_i) \
        __builtin_amdgcn_global_load_lds((const unsigned*)((const char*)(gbase) + (voff)[_i]), (LAS unsigned*)(lds + (bufoff) + ldsw + _i * 8192), 16, 0, 0); } while (0)
#define PG8_LDA(dst, b, h) do { _Pragma("unroll") for (int m = 0; m < 4; ++m) _Pragma("unroll") for (int k = 0; k < 2; ++k) dst[m][k] = *(const LAS bf16x8*)(lds + PG8_SA(b, h) + aoff + m * 2048 + k * 1024); } while (0)
#define PG8_LDB(dst, b, h) do { _Pragma("unroll") for (int n = 0; n < 2; ++n) _Pragma("unroll") for (int k = 0; k < 2; ++k) dst[n][k] = *(const LAS bf16x8*)(lds + PG8_SB(b, h) + boff + n * 2048 + k * 1024); } while (0)
#define PG8_MMA(ai, bj, At, Bt) do { __builtin_amdgcn_s_setprio(1); _Pragma("unroll") for (int m = 0; m < 4; ++m) _Pragma("unroll") for (int n = 0; n < 2; ++n) _Pragma("unroll") for (int k = 0; k < 2; ++k) \
        acc[ai][bj][m][n] = __builtin_amdgcn_mfma_f32_16x16x32_bf16(Bt[n][k], At[m][k], acc[ai][bj][m][n], 0, 0, 0); __builtin_amdgcn_s_setprio(0); } while (0)
#define PG8_WAIT_V(n) asm volatile("s_waitcnt vmcnt(" #n ")" ::: "memory")
#define PG8_WAIT_L(n) asm volatile("s_waitcnt lgkmcnt(" #n ")" ::: "memory")
#define PG8_BAR __builtin_amdgcn_s_barrier()
#define PG8_SCHED __builtin_amdgcn_sched_barrier(0)
    Unit cur, nxt; int ui = 0;
    if (!S.next(0, cur)) return;
    f32x4 acc[2][2][4][2];
#pragma unroll
    for (int a = 0; a < 2; ++a)
#pragma unroll
        for (int b = 0; b < 2; ++b)
#pragma unroll
            for (int m = 0; m < 4; ++m)
#pragma unroll
                for (int n = 0; n < 2; ++n) acc[a][b][m][n] = (f32x4){0.f, 0.f, 0.f, 0.f};
    bf16x8 At[4][2], B0[2][2], B1[2][2];
    const char* cA = (const char*)g.A + (size_t)cur.pm * tstepA + (size_t)cur.pn * pstepA + (size_t)cur.pz * zstepA; const char* cB = (const char*)g.Bt + (size_t)cur.pn * tstepB + (size_t)cur.pz * zstepB;
    S.a_ready(cur);
    if constexpr (SP2) {
        PG8_STAGE(PG8_SB(0, 0), cB, voffB); PG8_STAGE(PG8_SB(0, 1), cB + hstepB, voffB); PG8_STAGE(PG8_SA(0, 0), cA, voffA); PG8_STAGE(PG8_SA(0, 1), cA + hstepA, voffA);
        if (wr == 1) PG8_BAR;
        PG8_WAIT_V(2); PG8_BAR;
        PG8_STAGE(PG8_SB(1, 0), cB + kstep, voffB); PG8_STAGE(PG8_SA(1, 0), cA + kstep, voffA); PG8_STAGE(PG8_SB(1, 1), cB + hstepB + kstep, voffB);
        PG8_WAIT_V(6); PG8_BAR;
    } else {
    PG8_STAGE(PG8_SB(0, 0), cB, voffB); PG8_STAGE(PG8_SA(0, 0), cA, voffA); PG8_STAGE(PG8_SB(0, 1), cB + hstepB, voffB); PG8_STAGE(PG8_SA(0, 1), cA + hstepA, voffA);
    if (wr == 1) PG8_BAR;
    PG8_WAIT_V(4); PG8_BAR;
    PG8_STAGE(PG8_SB(1, 0), cB + kstep, voffB); PG8_STAGE(PG8_SA(1, 0), cA + kstep, voffA); PG8_STAGE(PG8_SB(1, 1), cB + hstepB + kstep, voffB);
    PG8_WAIT_V(6); PG8_BAR;
    }
    for (;;) {
        const bool has_next = S.next(ui + 1, nxt);
        const char* nA = has_next ? (const char*)g.A + (size_t)nxt.pm * tstepA + (size_t)nxt.pn * pstepA + (size_t)nxt.pz * zstepA : cA; const char* nB = has_next ? (const char*)g.Bt + (size_t)nxt.pn * tstepB + (size_t)nxt.pz * zstepB : cB;
        for (int t = 0; t < nt; t += 2) {
            const bool last = (t == nt - 2);
            const char* a1 = cA + (size_t)(t + 1) * kstep;
            const char* a2 = last ? nA : cA + (size_t)(t + 2) * kstep; const char* b2 = last ? nB : cB + (size_t)(t + 2) * kstep;
            const char* a3 = a2 + kstep; const char* b3 = b2 + kstep;
            if (last && has_next) S.a_ready(nxt);
            if constexpr (Epi::KHOOK) { if (t != 0 && (t & 7) == 0) E.khook(acc, cur, t >> 3, wr, wc, fr, fq); }
            if constexpr (SP2) {
            PG8_LDB(B0, 0, 0); PG8_LDB(B1, 0, 1); PG8_SCHED; PG8_LDA(At, 0, 0); PG8_STAGE(PG8_SA(1, 1), a1 + hstepA, voffA);
            PG8_WAIT_V(8); PG8_WAIT_L(0); PG8_BAR; PG8_MMA(0, 0, At, B0); PG8_MMA(0, 1, At, B1); PG8_BAR; PG8_SCHED;
            PG8_LDA(At, 0, 1); PG8_STAGE(PG8_SB(0, 0), b2, voffB); PG8_STAGE(PG8_SB(0, 1), b2 + hstepB, voffB); PG8_STAGE(PG8_SA(0, 0), a2, voffA);
            PG8_WAIT_V(8); PG8_WAIT_L(0); PG8_BAR; PG8_MMA(1, 0, At, B0); PG8_MMA(1, 1, At, B1); PG8_BAR; PG8_SCHED;
            PG8_LDB(B0, 1, 0); PG8_LDB(B1, 1, 1); PG8_SCHED; PG8_LDA(At, 1, 0); PG8_STAGE(PG8_SA(0, 1), a2 + hstepA, voffA);
            PG8_WAIT_V(8); PG8_WAIT_L(0); PG8_BAR; PG8_MMA(0, 0, At, B0); PG8_MMA(0, 1, At, B1); PG8_BAR; PG8_SCHED;
            PG8_LDA(At, 1, 1); PG8_STAGE(PG8_SB(1, 0), b3, voffB); PG8_STAGE(PG8_SB(1, 1), b3 + hstepB, voffB); PG8_STAGE(PG8_SA(1, 0), a3, voffA);
            PG8_WAIT_V(8); PG8_WAIT_L(0); PG8_BAR; PG8_MMA(1, 0, At, B0); PG8_MMA(1, 1, At, B1); PG8_BAR; PG8_SCHED;
            } else {
            PG8_LDB(B0, 0, 0); PG8_SCHED; PG8_LDA(At, 0, 0); PG8_STAGE(PG8_SA(1, 1), a1 + hstepA, voffA);
            PG8_WAIT_L(8); PG8_BAR; PG8_WAIT_L(0); PG8_MMA(0, 0, At, B0); PG8_BAR; PG8_SCHED;
            PG8_LDB(B1, 0, 1); PG8_STAGE(PG8_SB(0, 0), b2, voffB);
            PG8_BAR; PG8_WAIT_L(0); PG8_MMA(0, 1, At, B1); PG8_BAR;
            PG8_LDA(At, 0, 1); PG8_STAGE(PG8_SA(0, 0), a2, voffA);
            PG8_BAR; PG8_WAIT_L(0); PG8_MMA(1, 0, At, B0); PG8_BAR; PG8_SCHED;
            PG8_STAGE(PG8_SB(0, 1), b2 + hstepB, voffB);
            PG8_WAIT_V(6); PG8_BAR; PG8_MMA(1, 1, At, B1); PG8_BAR;
            PG8_LDB(B0, 1, 0); PG8_SCHED; PG8_LDA(At, 1, 0); PG8_STAGE(PG8_SA(0, 1), a2 + hstepA, voffA);
            PG8_WAIT_L(8); PG8_BAR; PG8_WAIT_L(0); PG8_MMA(0, 0, At, B0); PG8_BAR; PG8_SCHED;
            PG8_LDB(B1, 1, 1); PG8_STAGE(PG8_SB(1, 0), b3, voffB);
            PG8_BAR; PG8_WAIT_L(0); PG8_MMA(0, 1, At, B1); PG8_BAR;
            PG8_LDA(At, 1, 1); PG8_STAGE(PG8_SA(1, 0), a3, voffA);
            PG8_BAR; PG8_WAIT_L(0); PG8_MMA(1, 0, At, B0); PG8_BAR; PG8_SCHED;
            PG8_STAGE(PG8_SB(1, 1), b3 + hstepB, voffB);
            PG8_WAIT_V(6); PG8_BAR; PG8_MMA(1, 1, At, B1); PG8_BAR;
            }
        }
        E(acc, cur, wr, wc, fr, fq); S.done(cur);
        if (!has_next) break;
#pragma unroll
        for (int a = 0; a < 2; ++a)
#pragma unroll
            for (int b = 0; b < 2; ++b)
#pragma unroll
                for (int m = 0; m < 4; ++m)
#pragma unroll
                    for (int n = 0; n < 2; ++n) acc[a][b][m][n] = (f32x4){0.f, 0.f, 0.f, 0.f};
        cur = nxt; cA = nA; cB = nB; ++ui;
    }
    PG8_WAIT_V(0);
    if (wr == 0) PG8_BAR;
    PG8_BAR;
#undef PG8_SA
#undef PG8_SB
#undef PG8_STAGE
#undef PG8_LDA
#undef PG8_LDB
#undef PG8_MMA
#undef PG8_WAIT_V
#undef PG8_WAIT_L
#undef PG8_BAR
#undef PG8_SCHED
}
}

#define XB_TMO      128
#define XB_XCNT(j)  (256  + 64 * (j))
#define XB_XSUB(j)  (1280 + 64 * (j))
#define XB_XGEN(j)  (2304 + 64 * (j))
#define XB_TOP      3328
#define XB_TOPGEN   3392
#define XCD_BAR_WORDS 3456
#define XB_SPIN_CAP (1u << 20)
__device__ __forceinline__ unsigned xb_ld(unsigned* p)              { return __hip_atomic_load(p, __ATOMIC_RELAXED, __HIP_MEMORY_SCOPE_AGENT); }
__device__ __forceinline__ unsigned xb_add(unsigned* p, unsigned v) { return __hip_atomic_fetch_add(p, v, __ATOMIC_RELAXED, __HIP_MEMORY_SCOPE_AGENT); }
__device__ __forceinline__ unsigned xb_xcc_id() { return (unsigned)__builtin_amdgcn_s_getreg((3 << 11) | 20) & 0xFu; }
#define XB_SPIN(cond, bar) do { unsigned _sp = 0; while (cond) { __builtin_amdgcn_s_sleep(1); \
    if ((++_sp & 255u) == 0u) { if (xb_ld(&(bar)[XB_TMO])) break; if (_sp > XB_SPIN_CAP) { atomicAdd(&(bar)[XB_TMO], 1u); break; } } } } while (0)
struct XcdBarrier { unsigned* bar; unsigned x; volatile LAS unsigned* st; };
__device__ __forceinline__ XcdBarrier xcd_barrier_post(unsigned* bar, volatile LAS unsigned* st) {
    XcdBarrier b; b.bar = bar; b.x = xb_xcc_id(); b.st = st;
    if (threadIdx.x == 0) (void)xb_add(&bar[XB_XCNT(b.x)], 1u);
    return b;
}
__device__ __forceinline__ void xcd_barrier_complete(unsigned* bar, unsigned x, unsigned& nloc, unsigned& nx) {
    const unsigned G = gridDim.x * gridDim.y * gridDim.z;
    unsigned sum, cnt, mine, sp = 0u;
    for (;;) {
        sum = 0u; cnt = 0u; mine = 0u;
#pragma unroll
        for (unsigned j = 0; j < 16; ++j) { const unsigned c = xb_ld(&bar[XB_XCNT(j)]); sum += c; cnt += (c > 0u) ? 1u : 0u; mine = (j == x) ? c : mine; }
        if (sum == G) break;
        __builtin_amdgcn_s_sleep(1);
        if ((++sp & 255u) == 0u) { if (xb_ld(&bar[XB_TMO])) break; if (sp > XB_SPIN_CAP) { atomicAdd(&bar[XB_TMO], 1u); break; } }
    }
    nloc = mine > 0u ? mine : 1u; nx = cnt > 0u ? cnt : 1u;
}
__device__ __forceinline__ void xcd_barrier(const XcdBarrier& b) {
    asm volatile("s_waitcnt vmcnt(0)" ::: "memory");
    __syncthreads();
    if (threadIdx.x == 0) {
        unsigned* bar = b.bar;
        __builtin_amdgcn_s_waitcnt(0);
        unsigned nloc = b.st[0], nx = b.st[1];
        if (nloc == 0u) { xcd_barrier_complete(bar, b.x, nloc, nx); b.st[0] = nloc; b.st[1] = nx; }
        const unsigned old = xb_add(&bar[XB_XSUB(b.x)], 1u);
        const unsigned gen = old / nloc;
        if (old + 1u == (gen + 1u) * nloc) {
            __builtin_amdgcn_fence(__ATOMIC_RELEASE, "agent");
            asm volatile("s_waitcnt vmcnt(0)" ::: "memory");
            const unsigned og = xb_add(&bar[XB_TOP], 1u);
            const unsigned tg = og / nx;
            if (og + 1u == (tg + 1u) * nx) xb_add(&bar[XB_TOPGEN], 1u);
            else XB_SPIN(xb_ld(&bar[XB_TOPGEN]) == tg, bar);
            __builtin_amdgcn_fence(__ATOMIC_ACQUIRE, "agent");
            xb_add(&bar[XB_XGEN(b.x)], 1u);
            asm volatile("s_waitcnt vmcnt(0)" ::: "memory");
        } else {
            XB_SPIN(xb_ld(&bar[XB_XGEN(b.x)]) == gen, bar);
            __builtin_amdgcn_fence(__ATOMIC_ACQUIRE, "agent");
            asm volatile("s_waitcnt vmcnt(0)" ::: "memory");
        }
    }
    __syncthreads();
}

constexpr size_t al256(size_t x) { return (x + 255) & ~(size_t)255; }
constexpr size_t WS_CTL   = 0;
constexpr size_t CTL_BYTES = 64 * 1024;
constexpr size_t WS_MOD   = WS_CTL + CTL_BYTES;
constexpr size_t WS_S5P   = WS_MOD + al256((size_t)DEPTH * BATCH * ADA * 4);
constexpr size_t WS_LB    = WS_S5P + al256((size_t)DEPTH * 32 * 64 * 36 * 4);
constexpr size_t WS_BCAT  = WS_LB + al256((size_t)DEPTH * BW * 4);
constexpr size_t WS_WBT   = WS_BCAT + (size_t)DEPTH * NCAT * D * 2;
constexpr size_t WS_WOT   = WS_WBT + (size_t)DEPTH * 4 * D * BW * 2;
constexpr size_t WS_WQT   = WS_WOT + (size_t)DEPTH * D * D * 2;
constexpr size_t WS_WGLUT = WS_WQT + (size_t)DEPTH * D * D * 2;
constexpr size_t WS_POOLT = WS_WGLUT + (size_t)DEPTH * BW * BW * 2;
constexpr size_t WS_KEYST = WS_POOLT + (size_t)DEPTH * BW * BW * 2;
constexpr size_t WS_PU8   = WS_KEYST + (size_t)DEPTH * D * 256 * 2;
constexpr size_t WS_PV8   = WS_PU8 + (size_t)DEPTH * NEXP * D;
constexpr size_t WS_SU    = WS_PV8 + (size_t)DEPTH * NEXP * D;
constexpr size_t WS_SV    = WS_SU + (size_t)DEPTH * NEXP * 4;
constexpr size_t WS_H     = WS_SV + (size_t)DEPTH * NEXP * 4;
constexpr size_t WS_PROJ  = WS_H + (size_t)M * D * 2;
constexpr size_t WS_G8    = WS_PROJ + (size_t)M * INC * 2;
constexpr size_t WS_YG    = WS_G8 + (size_t)M * 4 * D;
constexpr size_t WS_POOLED= WS_YG + (size_t)M * BW * 2;
constexpr size_t WS_EIDX  = WS_POOLED + (size_t)M * BW * 2;
constexpr size_t WS_GATE  = WS_EIDX + (size_t)M * 128 * 4;
constexpr size_t WS_YCAT  = WS_GATE + (size_t)M * 128 * 4;
constexpr size_t WS_END   = WS_YCAT + (size_t)M * D * 2;
constexpr size_t WS_RSS   = WS_PROJ + (size_t)M * D * 2;
constexpr size_t WS_C0    = WS_RSS + (size_t)M * 8;
constexpr float RSS_SCALE = 16777216.0f, RSS_INV = 1.0f / 16777216.0f;
constexpr size_t WS_SD    = WS_C0 + (size_t)BATCH * D * 4;
static_assert(WS_SD + (size_t)BATCH * NEXP * 4 <= WS_PROJ + (size_t)M * INC * 2, "aux tables must fit in the tail of PROJ");

constexpr int LDS_BYTES = 147456, MISC_OFF = 131072;
constexpr int CTR_WORD0 = 4096;

struct Params {
    const float *x, *c, *ada_w, *ada_b, *nmg, *nfg, *w_in, *lam_re, *lam_im, *log_step, *b_re, *b_im, *c_re, *c_im, *s5_d, *w_glu, *b_glu,
                *lb_logits, *hg_gain, *pool_w, *pool_scale, *w_gate, *w_branch, *w_out, *wq, *sub_keys, *peer_u, *peer_v, *final_gain;
    float* out; unsigned char* ws; int ph_lo, ph_hi;
};

struct Ctx { LAS unsigned char* lds; volatile LAS unsigned* misc; int tid, lane, wid, G; unsigned* ctl; };

__device__ __forceinline__ Ctx fresh(const Ctx& F) { Ctx R = F; int t = threadIdx.x; asm volatile("" : "+v"(t)); R.tid = t; R.lane = t & 63; R.wid = __builtin_amdgcn_readfirstlane(t >> 6); return R; }
__device__ __forceinline__ int next_item(const Ctx& F, int ctr, unsigned inc = 1u) {
    __syncthreads();
    if (F.tid == 0) F.misc[8] = __hip_atomic_fetch_add(F.ctl + CTR_WORD0 + 64 * ctr, inc, __ATOMIC_RELAXED, __HIP_MEMORY_SCOPE_AGENT);
    __syncthreads();
    return (int)F.misc[8];
}

__device__ __forceinline__ void pro_mod(const Ctx& F, const Params& p, int it) {
    const int l = it / 48, cb = it % 48;
    LAS float* cond = (LAS float*)F.lds;
    for (int i = F.tid; i < BATCH * D; i += 512) { const int b = i / D, k = i % D; const float v = p.c[i]; cond[k * 16 + b] = siluf_(v); }
    __syncthreads();
    float acc[16][4];
#pragma unroll
    for (int b = 0; b < 16; ++b)
#pragma unroll
        for (int j = 0; j < 4; ++j) acc[b][j] = 0.f;
    const int col = cb * 256 + F.lane * 4;
    const float* wp = p.ada_w + (size_t)l * D * ADA + col;
    const int k0 = F.wid * 256;
#pragma unroll 4
    for (int kk = 0; kk < 256; ++kk) {
        const int k = k0 + kk;
        const f32x4 w = __builtin_nontemporal_load((const f32x4*)(wp + (size_t)k * ADA));
        const LAS f32x4* cp = (const LAS f32x4*)(cond + k * 16);
#pragma unroll
        for (int q = 0; q < 4; ++q) { const f32x4 cv = cp[q];
#pragma unroll
            for (int r = 0; r < 4; ++r)
#pragma unroll
                for (int j = 0; j < 4; ++j) acc[q * 4 + r][j] += cv[r] * w[j]; }
    }
    __syncthreads();
    LAS float* red = (LAS float*)F.lds;
#pragma unroll
    for (int b = 0; b < 16; ++b)
#pragma unroll
        for (int j = 0; j < 4; ++j) red[(F.wid * 16 + b) * 256 + F.lane * 4 + j] = acc[b][j];
    __syncthreads();
    for (int o = F.tid; o < 16 * 256; o += 512) { const int b = o / 256, cc = o % 256; float s = 0.f;
#pragma unroll
        for (int w = 0; w < 8; ++w) s += red[(w * 16 + b) * 256 + cc];
        const int n = cb * 256 + cc;
        ((float*)(p.ws + WS_MOD))[((size_t)l * BATCH + b) * ADA + n] = s + p.ada_b[(size_t)l * ADA + n]; }
}
__device__ __forceinline__ void pro_transpose_tile(const Ctx& F, const float* src, int N, bf16_t* dst, int ldd, int k0, int n0) {
    LAS float* tile = (LAS float*)F.lds;
#pragma unroll
    for (int ps = 0; ps < 4; ++ps) { const int row = ps * 32 + (F.tid >> 4), c4 = (F.tid & 15) * 4;
        const f32x4 v = __builtin_nontemporal_load((const f32x4*)(src + (size_t)(k0 + row) * N + n0 + c4));
        tile[row * 65 + c4 + 0] = v[0]; tile[row * 65 + c4 + 1] = v[1]; tile[row * 65 + c4 + 2] = v[2]; tile[row * 65 + c4 + 3] = v[3]; }
    __syncthreads();
    const int n = F.tid >> 3, ks = (F.tid & 7) * 16;
    unsigned w[8];
#pragma unroll
    for (int i = 0; i < 8; ++i) w[i] = cvt_pk_bf16(tile[(ks + 2 * i) * 65 + n], tile[(ks + 2 * i + 1) * 65 + n]);
    u32x4* dp = (u32x4*)(dst + (size_t)(n0 + n) * ldd + k0 + ks);
    dp[0] = (u32x4){w[0], w[1], w[2], w[3]}; dp[1] = (u32x4){w[4], w[5], w[6], w[7]};
}
constexpr int TT_WIN = 16 * 72, TT_GATE = 16 * 32, TT_BR = 4 * 32, TT_SQ = 16 * 32, TT_GLU = 4 * 8;
constexpr int TT_LAYER = TT_WIN + 4 * TT_GATE + 4 * TT_BR + TT_SQ + TT_GLU;
__device__ __forceinline__ void pro_transpose(const Ctx& F, const Params& p, int it) {
    const int l = it / TT_LAYER; int r = it % TT_LAYER;
    const float* src; int N; bf16_t* dst; int ldd; int ntn;
    if (r < TT_WIN) { src = p.w_in + (size_t)l * D * INC; N = INC; dst = (bf16_t*)(p.ws + WS_BCAT) + (size_t)l * NCAT * D; ldd = D; ntn = 72; }
    else if ((r -= TT_WIN) < 4 * TT_GATE) { const int j = r / TT_GATE; r %= TT_GATE; src = p.w_gate + ((size_t)l * 4 + j) * D * D; N = D; dst = (bf16_t*)(p.ws + WS_BCAT) + ((size_t)l * NCAT + INC + (size_t)j * D) * D; ldd = D; ntn = 32; }
    else if ((r -= 4 * TT_GATE) < 4 * TT_BR) { const int j = r / TT_BR; r %= TT_BR; src = p.w_branch + ((size_t)l * 4 + j) * BW * D; N = D; dst = (bf16_t*)(p.ws + WS_WBT) + (size_t)l * D * D + (size_t)j * BW; ldd = D; ntn = 32; }
    else if ((r -= 4 * TT_BR) < TT_SQ) { src = p.w_out + (size_t)l * D * D; N = D; dst = (bf16_t*)(p.ws + WS_WOT) + (size_t)l * D * D; ldd = D; ntn = 32; }
    else { r -= TT_SQ; src = p.w_glu + (size_t)l * BW * BW; N = BW; dst = (bf16_t*)(p.ws + WS_WGLUT) + (size_t)l * BW * BW; ldd = BW; ntn = 8; }
    const int tk = r / ntn, tn = r % ntn;
    pro_transpose_tile(F, src, N, dst, ldd, tk * 128, tn * 64);
}
__device__ __forceinline__ void pro_qk(const Ctx& F, const Params& p, int it) {
    const int l = it >> 9, r = it & 511, kb = r >> 4, hp = r & 15;
    LAS float* qs = (LAS float*)F.lds;
    LAS float* ks = qs + 64 * 132;
    const float* wq = p.wq + (size_t)l * D * D + (size_t)(kb * 64) * D + hp * 128;
    const float* ky = p.sub_keys + ((size_t)l * 16 + hp) * 128 * 128;
    for (int i = F.tid; i < 64 * 32; i += 512) { const int row = i >> 5, c4 = (i & 31) * 4; *(LAS f32x4*)(qs + row * 132 + c4) = __builtin_nontemporal_load((const f32x4*)(wq + (size_t)row * D + c4)); }
    for (int i = F.tid; i < 128 * 32; i += 512) { const int row = i >> 5, c4 = (i & 31) * 4; *(LAS f32x4*)(ks + row * 132 + c4) = *(const f32x4*)(ky + (size_t)row * 128 + c4); }
    __syncthreads();
    const int fr = F.lane & 15, fq = F.lane >> 4, kblk = F.wid & 3, nb0 = (F.wid >> 2) * 4;
    f32x4 acc[4];
#pragma unroll
    for (int nb = 0; nb < 4; ++nb) acc[nb] = (f32x4){0.f, 0.f, 0.f, 0.f};
#pragma unroll
    for (int kk = 0; kk < 4; ++kk) {
        const LAS float* ap = qs + (kblk * 16 + fr) * 132 + kk * 32 + fq * 8;
        const f32x4 a0 = *(const LAS f32x4*)ap, a1 = *(const LAS f32x4*)(ap + 4);
        const u32x4 aw = (u32x4){cvt_pk_bf16(a0[0], a0[1]), cvt_pk_bf16(a0[2], a0[3]), cvt_pk_bf16(a1[0], a1[1]), cvt_pk_bf16(a1[2], a1[3])};
#pragma unroll
        for (int nb = 0; nb < 4; ++nb) {
            const LAS float* bp = ks + ((nb0 + nb) * 16 + fr) * 132 + kk * 32 + fq * 8;
            const f32x4 b0 = *(const LAS f32x4*)bp, b1 = *(const LAS f32x4*)(bp + 4);
            const u32x4 bw = (u32x4){cvt_pk_bf16(b0[0], b0[1]), cvt_pk_bf16(b0[2], b0[3]), cvt_pk_bf16(b1[0], b1[1]), cvt_pk_bf16(b1[2], b1[3])};
            acc[nb] = __builtin_amdgcn_mfma_f32_16x16x32_bf16(__builtin_bit_cast(bf16x8, aw), __builtin_bit_cast(bf16x8, bw), acc[nb], 0, 0, 0); } }
#pragma unroll
    for (int nb = 0; nb < 4; ++nb) {
        bf16_t* dst = (bf16_t*)(p.ws + WS_WQT) + ((size_t)l * D + hp * 128 + (nb0 + nb) * 16 + fr) * D + kb * 64 + kblk * 16 + 4 * fq;
        *(u32x2*)dst = (u32x2){cvt_pk_bf16(acc[nb][0], acc[nb][1]), cvt_pk_bf16(acc[nb][2], acc[nb][3])}; }
}
__device__ __forceinline__ void pro_small(const Ctx& F, const Params& p, int it) {
    if (it < 1024) {
        const int o = it * 512 + F.tid, l = o >> 18, r = o & 262143, n = r >> 9, k = r & 511, g = n >> 7, d = n & 127, g2 = k >> 7, c = k & 127;
        const float v = (g == g2) ? p.pool_w[(((size_t)l * 4 + g) * 128 + c) * 128 + d] * p.pool_scale[l * BW + n] : 0.f;
        ((bf16_t*)(p.ws + WS_POOLT))[o] = f2bf(v);
    } else if (it < 1024 + 2048) {
    } else if (it < 1024 + 2048 + 8) {
        const int o = (it - 3072) * 512 + F.tid, l = o >> 11, g = (o >> 6) & 31;
        const float lr = fminf(p.lam_re[o], -1e-4f), li = p.lam_im[o], step = expf(p.log_step[l * 32 + g]);
        const float mag = expf(lr * step); float sn, cs; sincosf(li * step, &sn, &cs);
        const float are = mag * cs, aim = mag * sn, den = lr * lr + li * li, nr = are - 1.0f;
        const float fr = (nr * lr + aim * li) / den, fi = (aim * lr - nr * li) / den;
        float* q = (float*)(p.ws + WS_S5P) + (size_t)o * 36;
        q[0] = are; q[1] = aim; q[2] = 0.f; q[3] = 0.f;
#pragma unroll
        for (int h = 0; h < 16; ++h) { const float br = p.b_re[(size_t)o * 16 + h], bi = p.b_im[(size_t)o * 16 + h]; q[4 + h] = fr * br - fi * bi; q[20 + h] = fr * bi + fi * br; }
    } else {
        const int o = (it - 3080) * 512 + F.tid, l = o >> 9, j = o & 511;
        const float a0 = p.lb_logits[j], a1 = p.lb_logits[BW + j];
        ((float*)(p.ws + WS_LB))[o] = (l == 0) ? 0.f : 1.0f / (1.0f + expf(a0 - a1));
    }
}
__device__ __forceinline__ void pro_peer(const Ctx& F, const Params& p, int it) {
    const int row = it * 8 + F.wid, tb = row >> 15, le = row & 32767, l = le >> 14, e = le & 16383;
    const float* src = (tb ? p.peer_v : p.peer_u) + (size_t)le * D;
    f32x4 v[8]; float am = 0.f;
#pragma unroll
    for (int i = 0; i < 4; ++i) { v[2 * i] = __builtin_nontemporal_load((const f32x4*)(src + i * 512 + F.lane * 8)); v[2 * i + 1] = __builtin_nontemporal_load((const f32x4*)(src + i * 512 + F.lane * 8 + 4)); }
#pragma unroll
    for (int i = 0; i < 8; ++i) am = fmaxf(fmaxf(am, fmaxf(fabsf(v[i][0]), fabsf(v[i][1]))), fmaxf(fabsf(v[i][2]), fabsf(v[i][3])));
#pragma unroll
    for (int o = 32; o >= 1; o >>= 1) am = fmaxf(am, __shfl_xor(am, o));
    const float scale = am > 0.f ? am * (1.0f / 440.0f) : 1.0f, inv = 1.0f / scale;
    unsigned char* T8 = p.ws + (tb ? WS_PV8 : WS_PU8) + (size_t)l * 16 * NEXP * 128;
#pragma unroll
    for (int i = 0; i < 4; ++i) { const int slice = 4 * i + (F.lane >> 4), off = (F.lane & 15) * 8; int w0 = 0, w1 = 0;
        w0 = __builtin_amdgcn_cvt_pk_fp8_f32(v[2 * i][0] * inv, v[2 * i][1] * inv, w0, false); w0 = __builtin_amdgcn_cvt_pk_fp8_f32(v[2 * i][2] * inv, v[2 * i][3] * inv, w0, true);
        w1 = __builtin_amdgcn_cvt_pk_fp8_f32(v[2 * i + 1][0] * inv, v[2 * i + 1][1] * inv, w1, false); w1 = __builtin_amdgcn_cvt_pk_fp8_f32(v[2 * i + 1][2] * inv, v[2 * i + 1][3] * inv, w1, true);
        *(u32x2*)(T8 + ((size_t)slice * NEXP + e) * 128 + off) = (u32x2){(unsigned)w0, (unsigned)w1}; }
    if (F.lane == 0) ((float*)(p.ws + (tb ? WS_SV : WS_SU)))[le] = scale;
}
constexpr int PRO_MOD = 96, PRO_TT = 2 * TT_LAYER, PRO_SMALL = 1024 + 2048 + 8 + 2, PRO_PEER = 2 * DEPTH * NEXP / 8, PRO_QK = DEPTH * 512;
__device__ __forceinline__ void phase_prologue(const Ctx& F, const Params& p) {
    for (;;) { const int it = next_item(F, 0); if (it >= PRO_MOD) break; pro_mod(F, p, it); }
    constexpr int PRO_REST = PRO_QK + PRO_TT + PRO_SMALL + PRO_PEER;
    for (;;) {
        const int base = next_item(F, 3, 4u);
        if (base >= PRO_REST) break;
#pragma unroll 1
        for (int q = 0; q < 4; ++q) { int it = base + q; if (it >= PRO_REST) break;
            __syncthreads();
            if (it < PRO_QK) pro_qk(F, p, it);
            else if ((it -= PRO_QK) < PRO_TT) pro_transpose(F, p, it);
            else if ((it -= PRO_TT) < PRO_SMALL) pro_small(F, p, it);
            else pro_peer(F, p, it - PRO_SMALL); }
    }
}

template <int MODE>
__device__ __forceinline__ void norm_row(const Ctx& F, int r, const float* xin, const float* gain, const float* sh, const float* sc, bf16_t* hout, float* fout) {
    {
        const int b = r / SEQ;
        const f32x4* xp = (const f32x4*)(xin + (size_t)r * D);
        f32x4 v[8]; float ss = 0.f;
#pragma unroll
        for (int i = 0; i < 8; ++i) { v[i] = xp[i * 64 + F.lane]; ss += v[i][0] * v[i][0] + v[i][1] * v[i][1] + v[i][2] * v[i][2] + v[i][3] * v[i][3]; }
#pragma unroll
        for (int o = 32; o >= 1; o >>= 1) ss += __shfl_xor(ss, o);
        const float rs = rsqrtf(ss * (1.0f / D) + EPS);
#pragma unroll
        for (int i = 0; i < 8; ++i) { const int c = (i * 64 + F.lane) * 4; const f32x4 g = *(const f32x4*)(gain + c); f32x4 y = v[i] * rs * g;
            if (MODE == 0) { const f32x4 s1 = *(const f32x4*)(sc + (size_t)b * ADA + c), s0 = *(const f32x4*)(sh + (size_t)b * ADA + c); y = y * (s1 + 1.0f) + s0;
                *(u32x2*)(hout + (size_t)r * D + c) = (u32x2){cvt_pk_bf16(y[0], y[1]), cvt_pk_bf16(y[2], y[3])}; }
            else *(f32x4*)(fout + (size_t)r * D + c) = y; }
    }
}
template <int MODE, int NR>
__device__ __forceinline__ void norm_rows(const Ctx& F, int r, const float* xin, const float* gain, const float* sh, const float* sc, bf16_t* hout, float* fout) {
    const int b = r / SEQ;
    const f32x4* xp = (const f32x4*)(xin + (size_t)r * D);
    f32x4 v[NR][8]; float ss[NR];
#pragma unroll
    for (int i = 0; i < 8; ++i)
#pragma unroll
        for (int q = 0; q < NR; ++q) v[q][i] = xp[q * (D / 4) + i * 64 + F.lane];
#pragma unroll
    for (int q = 0; q < NR; ++q) { float a = 0.f;
#pragma unroll
        for (int i = 0; i < 8; ++i) a += v[q][i][0] * v[q][i][0] + v[q][i][1] * v[q][i][1] + v[q][i][2] * v[q][i][2] + v[q][i][3] * v[q][i][3];
        ss[q] = a; }
#pragma unroll
    for (int o = 32; o >= 1; o >>= 1)
#pragma unroll
        for (int q = 0; q < NR; ++q) ss[q] += __shfl_xor(ss[q], o);
#pragma unroll
    for (int q = 0; q < NR; ++q) ss[q] = rsqrtf(ss[q] * (1.0f / D) + EPS);
#pragma unroll
    for (int i = 0; i < 8; ++i) { const int c = (i * 64 + F.lane) * 4; const f32x4 g = *(const f32x4*)(gain + c);
        f32x4 s1, s0; if (MODE == 0) { s1 = *(const f32x4*)(sc + (size_t)b * ADA + c) + 1.0f; s0 = *(const f32x4*)(sh + (size_t)b * ADA + c); }
#pragma unroll
        for (int q = 0; q < NR; ++q) { f32x4 y = v[q][i] * ss[q] * g;
            if (MODE == 0) { y = y * s1 + s0; *(u32x2*)(hout + (size_t)(r + q) * D + c) = (u32x2){cvt_pk_bf16(y[0], y[1]), cvt_pk_bf16(y[2], y[3])}; }
            else *(f32x4*)(fout + (size_t)(r + q) * D + c) = y; } }
}
template <int MODE>
__device__ __forceinline__ void phase_norm(const Ctx& F, const float* xin, const float* gain, const float* sh, const float* sc, bf16_t* hout, float* fout) {
    for (int r = (blockIdx.x * 8 + F.wid) * 4; r < M; r += F.G * 32) norm_rows<MODE, 4>(F, r, xin, gain, sh, sc, hout, fout);
}

struct EpiGateT {
    static constexpr bool PERM = true; static constexpr bool KHOOK = false;
    unsigned char* g8;
    __device__ __forceinline__ void operator()(const f32x4 (&acc)[2][2][4][2], const pg8::Unit& u, int wr, int wc, int fr, int fq) const {
        unsigned char* tp = g8 + ((size_t)(u.pm * 32 + u.pn) * 512 + (size_t)((wr * 4 + wc) * 64 + fq * 16 + fr)) * 128;
#pragma unroll
        for (int ai = 0; ai < 2; ++ai)
#pragma unroll
            for (int m = 0; m < 4; ++m) { unsigned w[2][2];
#pragma unroll
                for (int bj = 0; bj < 2; ++bj)
#pragma unroll
                    for (int n = 0; n < 2; ++n) { const f32x4 v = acc[ai][bj][m][n]; unsigned q = 0;
#pragma unroll
                        for (int j = 0; j < 4; ++j) { const unsigned b = (unsigned)fminf(__builtin_amdgcn_rcpf(__builtin_fmaf(__expf(-v[j]), 0.00390625f, 0.00390625f)), 255.0f); q |= b << (8 * j); }
                        w[bj][n] = q; }
                *(u32x4*)(tp + (ai * 4 + m) * 16) = (u32x4){w[0][0], w[0][1], w[1][0], w[1][1]}; }
    }
};
struct EpiGlu {
    static constexpr bool PERM = true; static constexpr bool KHOOK = false;
    const bf16_t* yg; const float* bglu; bf16_t* ycat;
    __device__ __forceinline__ void operator()(const f32x4 (&acc)[2][2][4][2], const pg8::Unit& u, int wr, int wc, int fr, int fq) const {
        const int row0 = u.pm * 256 + wr * 64 + fr, col0 = u.pn * 256 + wc * 32 + 8 * fq;
        f32x4 bq[2][2];
#pragma unroll
        for (int bj = 0; bj < 2; ++bj) { bq[bj][0] = *(const f32x4*)(bglu + col0 + bj * 128); bq[bj][1] = *(const f32x4*)(bglu + col0 + bj * 128 + 4); }
#pragma unroll
        for (int ai = 0; ai < 2; ++ai) {
            u32x4 yq[4][2];
#pragma unroll
            for (int m = 0; m < 4; ++m)
#pragma unroll
                for (int bj = 0; bj < 2; ++bj) yq[m][bj] = *(const u32x4*)(yg + (size_t)(row0 + ai * 128 + m * 16) * BW + col0 + bj * 128);
#pragma unroll
            for (int m = 0; m < 4; ++m) { const size_t row = (size_t)(row0 + ai * 128 + m * 16);
#pragma unroll
                for (int bj = 0; bj < 2; ++bj) { const int col = col0 + bj * 128;
                    const u32x4 yv = yq[m][bj]; const f32x4 b0 = bq[bj][0], b1 = bq[bj][1];
                    const f32x4 v0 = acc[ai][bj][m][0] + b0, v1 = acc[ai][bj][m][1] + b1;
                    float o[8]; o[0] = bflo(yv[0]) * sigmoidf_(v0[0]); o[1] = bfhi(yv[0]) * sigmoidf_(v0[1]); o[2] = bflo(yv[1]) * sigmoidf_(v0[2]); o[3] = bfhi(yv[1]) * sigmoidf_(v0[3]);
                    o[4] = bflo(yv[2]) * sigmoidf_(v1[0]); o[5] = bfhi(yv[2]) * sigmoidf_(v1[1]); o[6] = bflo(yv[3]) * sigmoidf_(v1[2]); o[7] = bfhi(yv[3]) * sigmoidf_(v1[3]);
                    *(u32x4*)(ycat + row * D + col) = (u32x4){cvt_pk_bf16(o[0], o[1]), cvt_pk_bf16(o[2], o[3]), cvt_pk_bf16(o[4], o[5]), cvt_pk_bf16(o[6], o[7])}; } } }
    }
};
struct EpiBf16 {
    static constexpr bool PERM = true; static constexpr bool KHOOK = false;
    bf16_t* O; int ldc; int coff;
    __device__ __forceinline__ void operator()(const f32x4 (&acc)[2][2][4][2], const pg8::Unit& u, int wr, int wc, int fr, int fq) const {
        const int row0 = u.pm * 256 + wr * 64 + fr, col0 = coff + u.pn * 256 + wc * 32 + 8 * fq;
#pragma unroll
        for (int ai = 0; ai < 2; ++ai)
#pragma unroll
            for (int m = 0; m < 4; ++m) { bf16_t* rowp = O + (size_t)(row0 + ai * 128 + m * 16) * ldc + col0;
#pragma unroll
                for (int bj = 0; bj < 2; ++bj) { const f32x4 v0 = acc[ai][bj][m][0], v1 = acc[ai][bj][m][1];
                    *(u32x4*)(rowp + bj * 128) = (u32x4){cvt_pk_bf16(v0[0], v0[1]), cvt_pk_bf16(v0[2], v0[3]), cvt_pk_bf16(v1[0], v1[1]), cvt_pk_bf16(v1[2], v1[3])}; } }
    }
};
struct EpiMerge {
    static constexpr bool PERM = true; static constexpr bool KHOOK = true;
    const unsigned char* g8; bf16_t* mg;
    __device__ __forceinline__ const unsigned char* tile(const pg8::Unit& u, int n, int wr, int wc, int fr, int fq) const {
        return g8 + ((size_t)(u.pm * 32 + n * 8 + u.pn) * 512 + (size_t)((wr * 4 + wc) * 64 + fq * 16 + fr)) * 128; }
    __device__ __forceinline__ void khook(f32x4 (&acc)[2][2][4][2], const pg8::Unit& u, int j, int wr, int wc, int fr, int fq) const {
        const unsigned char* ta = tile(u, j - 1, wr, wc, fr, fq); const unsigned char* tb = tile(u, j, wr, wc, fr, fq);
        u32x4 ga[2], gb[2];
        ga[0] = *(const u32x4*)ta; gb[0] = *(const u32x4*)tb; ga[1] = *(const u32x4*)(ta + 16); gb[1] = *(const u32x4*)(tb + 16);
#pragma unroll
        for (int q = 0; q < 8; ++q) { const int ai = q >> 2, m = q & 3; const u32x4 a4 = ga[q & 1], b4 = gb[q & 1];
            if (q + 2 < 8) { ga[q & 1] = *(const u32x4*)(ta + (q + 2) * 16); gb[q & 1] = *(const u32x4*)(tb + (q + 2) * 16); }
#pragma unroll
            for (int bj = 0; bj < 2; ++bj)
#pragma unroll
                for (int n = 0; n < 2; ++n) { const unsigned wa = a4[bj * 2 + n], wb = b4[bj * 2 + n];
#pragma unroll
                    for (int jj = 0; jj < 4; ++jj) acc[ai][bj][m][n][jj] *= ((float)((wa >> (8 * jj)) & 255u) + 0.5f) * __builtin_amdgcn_rcpf((float)((wb >> (8 * jj)) & 255u) + 0.5f); } }
    }
    __device__ __forceinline__ void operator()(const f32x4 (&acc)[2][2][4][2], const pg8::Unit& u, int wr, int wc, int fr, int fq) const {
        const int row0 = u.pm * 256 + wr * 64 + fr, col0 = u.pn * 256 + wc * 32 + 8 * fq;
        const unsigned char* tp = tile(u, 3, wr, wc, fr, fq);
        u32x4 gq[8];
#pragma unroll
        for (int q = 0; q < 8; ++q) gq[q] = *(const u32x4*)(tp + q * 16);
#pragma unroll
        for (int q = 0; q < 8; ++q) { const int ai = q >> 2, m = q & 3; const size_t row = (size_t)(row0 + ai * 128 + m * 16); const u32x4 g4 = gq[q];
#pragma unroll
            for (int bj = 0; bj < 2; ++bj) { const f32x4 v0 = acc[ai][bj][m][0], v1 = acc[ai][bj][m][1]; float o[8];
#pragma unroll
                for (int jj = 0; jj < 4; ++jj) { o[jj] = v0[jj] * __builtin_fmaf((float)((g4[bj * 2] >> (8 * jj)) & 255u), 1.0f / 256.0f, 0.5f / 256.0f); o[4 + jj] = v1[jj] * __builtin_fmaf((float)((g4[bj * 2 + 1] >> (8 * jj)) & 255u), 1.0f / 256.0f, 0.5f / 256.0f); }
                *(u32x4*)(mg + row * D + col0 + bj * 128) = (u32x4){cvt_pk_bf16(o[0], o[1]), cvt_pk_bf16(o[2], o[3]), cvt_pk_bf16(o[4], o[5]), cvt_pk_bf16(o[6], o[7])}; } }
    }
};
struct EpiResid {
    static constexpr bool PERM = false; static constexpr bool KHOOK = false;
    const float* xin; const float* gvec; float* xout;
    __device__ __forceinline__ void operator()(const f32x4 (&acc)[2][2][4][2], const pg8::Unit& u, int wr, int wc, int fr, int fq) const {
        const int row0 = u.pm * 256 + wr * 64 + fr, col0 = u.pn * 256 + wc * 32 + 4 * fq, b = u.pm / 8;
        f32x4 gv[2][2];
#pragma unroll
        for (int bj = 0; bj < 2; ++bj)
#pragma unroll
            for (int n = 0; n < 2; ++n) gv[bj][n] = *(const f32x4*)(gvec + (size_t)b * ADA + col0 + bj * 128 + n * 16);
        f32x4 xv[2][4];
#pragma unroll
        for (int q = 0; q < 2; ++q)
#pragma unroll
            for (int c = 0; c < 4; ++c) xv[q][c] = *(const f32x4*)(xin + (size_t)(row0 + (q >> 2) * 128 + (q & 3) * 16) * D + col0 + (c >> 1) * 128 + (c & 1) * 16);
#pragma unroll
        for (int q = 0; q < 8; ++q) { const int ai = q >> 2, m = q & 3; const size_t off = (size_t)(row0 + ai * 128 + m * 16) * D + col0;
            f32x4 cur[4];
#pragma unroll
            for (int c = 0; c < 4; ++c) cur[c] = xv[q & 1][c];
            if (q + 2 < 8) {
#pragma unroll
                for (int c = 0; c < 4; ++c) xv[q & 1][c] = *(const f32x4*)(xin + (size_t)(row0 + ((q + 2) >> 2) * 128 + ((q + 2) & 3) * 16) * D + col0 + (c >> 1) * 128 + (c & 1) * 16); }
#pragma unroll
            for (int c = 0; c < 4; ++c) *(f32x4*)(xout + off + (c >> 1) * 128 + (c & 1) * 16) = cur[c] + gv[c >> 1][c & 1] * acc[ai][c >> 1][m][c & 1];
        }
    }
};
struct EpiResidN {
    static constexpr bool PERM = true; static constexpr bool KHOOK = false;
    const float* xin; const float* gvec; float* xout; const float* gain; const float* sc; bf16_t* hraw; unsigned long long* rss;
    __device__ __forceinline__ void operator()(const f32x4 (&acc)[2][2][4][2], const pg8::Unit& u, int wr, int wc, int fr, int fq) const {
        const int row0 = u.pm * 256 + wr * 64 + fr, col0 = u.pn * 256 + wc * 32 + 8 * fq, b = u.pm / 8;
        float ssq[8];
#pragma unroll
        for (int bj = 0; bj < 2; ++bj) { const int cb = col0 + bj * 128;
            const f32x4 gv0 = *(const f32x4*)(gvec + (size_t)b * ADA + cb), gv1 = *(const f32x4*)(gvec + (size_t)b * ADA + cb + 4);
            const f32x4 wm0 = *(const f32x4*)(gain + cb) * (*(const f32x4*)(sc + (size_t)b * ADA + cb) + 1.0f), wm1 = *(const f32x4*)(gain + cb + 4) * (*(const f32x4*)(sc + (size_t)b * ADA + cb + 4) + 1.0f);
            f32x4 xv[4][2];
#pragma unroll
            for (int q = 0; q < 4; ++q) { const float* xp = xin + (size_t)(row0 + (q >> 2) * 128 + (q & 3) * 16) * D + cb; xv[q][0] = __builtin_nontemporal_load((const f32x4*)xp); xv[q][1] = __builtin_nontemporal_load((const f32x4*)(xp + 4)); }
#pragma unroll
            for (int q = 0; q < 8; ++q) { const int ai = q >> 2, m = q & 3; const size_t off = (size_t)(row0 + ai * 128 + m * 16) * D + cb;
                f32x4 o0 = xv[q & 3][0], o1 = xv[q & 3][1];
                if (q + 4 < 8) { const float* xp = xin + (size_t)(row0 + ((q + 4) >> 2) * 128 + ((q + 4) & 3) * 16) * D + cb; xv[q & 3][0] = __builtin_nontemporal_load((const f32x4*)xp); xv[q & 3][1] = __builtin_nontemporal_load((const f32x4*)(xp + 4)); }
                o0 = o0 + gv0 * acc[ai][bj][m][0]; o1 = o1 + gv1 * acc[ai][bj][m][1];
                *(f32x4*)(xout + off) = o0; *(f32x4*)(xout + off + 4) = o1;
                const float ss = (o0[0] * o0[0] + o0[1] * o0[1] + o0[2] * o0[2] + o0[3] * o0[3]) + (o1[0] * o1[0] + o1[1] * o1[1] + o1[2] * o1[2] + o1[3] * o1[3]);
                ssq[q] = bj == 0 ? ss : ssq[q] + ss;
                const f32x4 y0 = o0 * wm0, y1 = o1 * wm1;
                *(u32x4*)(hraw + off) = (u32x4){cvt_pk_bf16(y0[0], y0[1]), cvt_pk_bf16(y0[2], y0[3]), cvt_pk_bf16(y1[0], y1[1]), cvt_pk_bf16(y1[2], y1[3])}; } }
#pragma unroll
        for (int q = 0; q < 8; ++q) { float ss = ssq[q]; ss += __shfl_xor(ss, 16); ss += __shfl_xor(ss, 32);
            if (fq == 0) (void)__hip_atomic_fetch_add(rss + row0 + (q >> 2) * 128 + (q & 3) * 16, (unsigned long long)(ss * RSS_SCALE), __ATOMIC_RELAXED, __HIP_MEMORY_SCOPE_AGENT); }
    }
};
struct EpiScore {
    static constexpr bool PERM = true; static constexpr bool KHOOK = false;
    bf16_t* C; const unsigned long long* rss; const float* c0;
    __device__ __forceinline__ void operator()(const f32x4 (&acc)[2][2][4][2], const pg8::Unit& u, int wr, int wc, int fr, int fq) const {
        const int row0 = u.pm * 256 + wr * 64 + fr, col0 = u.pn * 256 + wc * 32 + 8 * fq, b = u.pm / 8;
        f32x4 cv[2][2];
#pragma unroll
        for (int bj = 0; bj < 2; ++bj)
#pragma unroll
            for (int n = 0; n < 2; ++n) cv[bj][n] = *(const f32x4*)(c0 + (size_t)b * D + col0 + bj * 128 + n * 4);
        unsigned long long rq[8];
#pragma unroll
        for (int q = 0; q < 8; ++q) rq[q] = rss[row0 + (q >> 2) * 128 + (q & 3) * 16];
#pragma unroll
        for (int ai = 0; ai < 2; ++ai)
#pragma unroll
            for (int m = 0; m < 4; ++m) { const int row = row0 + ai * 128 + m * 16; bf16_t* rowp = C + (size_t)row * D + col0; const float rs = rsqrtf((float)rq[ai * 4 + m] * (RSS_INV / D) + EPS);
#pragma unroll
                for (int bj = 0; bj < 2; ++bj) { const f32x4 v0 = acc[ai][bj][m][0] * rs + cv[bj][0], v1 = acc[ai][bj][m][1] * rs + cv[bj][1];
                    *(u32x4*)(rowp + bj * 128) = (u32x4){cvt_pk_bf16(v0[0], v0[1]), cvt_pk_bf16(v0[2], v0[3]), cvt_pk_bf16(v1[0], v1[1]), cvt_pk_bf16(v1[2], v1[3])}; } }
    }
};
__device__ __forceinline__ void aux_shift_tables(const Ctx& F, const Params& p, int l) {
    const float* sh = (const float*)(p.ws + WS_MOD) + (size_t)l * BATCH * ADA + 3 * D;
    unsigned long long* rss = (unsigned long long*)(p.ws + WS_RSS); float* c0 = (float*)(p.ws + WS_C0); float* sd = (float*)(p.ws + WS_SD);
    LAS unsigned char* shb = F.lds;
    LAS f32x4* red = (LAS f32x4*)(F.lds + 16 * 4112);
    __syncthreads();
    for (int i = blockIdx.x * 512 + F.tid; i < M; i += F.G * 512) rss[i] = 0ull;
    for (int i = F.tid; i < 16 * 512; i += 512) { const int b = i >> 9, c4 = (i & 511) * 4; const f32x4 v = *(const f32x4*)(sh + (size_t)b * ADA + c4);
        *(LAS u32x2*)(shb + b * 4112 + c4 * 2) = (u32x2){cvt_pk_bf16(v[0], v[1]), cvt_pk_bf16(v[2], v[3])}; }
    __syncthreads();
    const int fr = F.lane & 15, fq = F.lane >> 4;
    const LAS unsigned char* ap = shb + fr * 4112 + fq * 16;
    for (int eb = blockIdx.x; eb < NEXP / 64; eb += F.G) {
        const int nb = F.wid & 3, kh = F.wid >> 2, e = eb * 64 + nb * 16 + fr;
        const unsigned char* up = p.ws + WS_PU8 + (size_t)l * 16 * NEXP * 128 + (size_t)e * 128 + fq * 8;
        f32x4 acc = (f32x4){0.f, 0.f, 0.f, 0.f};
#pragma unroll 2
        for (int s = kh * 8; s < kh * 8 + 8; ++s) {
            u32x2 w[4];
#pragma unroll
            for (int kk = 0; kk < 4; ++kk) w[kk] = *(const u32x2*)(up + (size_t)s * NEXP * 128 + kk * 32);
#pragma unroll
            for (int kk = 0; kk < 4; ++kk) {
                const f32x2 a0 = __builtin_amdgcn_cvt_pk_f32_fp8((int)w[kk][0], false), a1 = __builtin_amdgcn_cvt_pk_f32_fp8((int)w[kk][0], true);
                const f32x2 a2 = __builtin_amdgcn_cvt_pk_f32_fp8((int)w[kk][1], false), a3 = __builtin_amdgcn_cvt_pk_f32_fp8((int)w[kk][1], true);
                const u32x4 bw = (u32x4){cvt_pk_bf16(a0[0], a0[1]), cvt_pk_bf16(a1[0], a1[1]), cvt_pk_bf16(a2[0], a2[1]), cvt_pk_bf16(a3[0], a3[1])};
                const bf16x8 af = *(const LAS bf16x8*)(ap + (s * 128 + kk * 32) * 2);
                acc = __builtin_amdgcn_mfma_f32_16x16x32_bf16(af, __builtin_bit_cast(bf16x8, bw), acc, 0, 0, 0); } }
        if (kh == 1) red[(F.wid - 4) * 64 + F.lane] = acc;
        __syncthreads();
        if (kh == 0) { const f32x4 o = acc + red[F.wid * 64 + F.lane];
#pragma unroll
            for (int r = 0; r < 4; ++r) sd[(size_t)(4 * fq + r) * NEXP + e] = o[r]; }
        __syncthreads();
    }
    for (int nbk = blockIdx.x; nbk < D / 16; nbk += F.G) {
        const bf16_t* wp = (const bf16_t*)(p.ws + WS_WQT) + (size_t)l * D * D + (size_t)(nbk * 16 + fr) * D + F.wid * 256 + fq * 8;
        f32x4 acc = (f32x4){0.f, 0.f, 0.f, 0.f};
#pragma unroll
        for (int kk = 0; kk < 8; ++kk) { const bf16x8 bf = *(const bf16x8*)(wp + kk * 32); const bf16x8 af = *(const LAS bf16x8*)(ap + (F.wid * 256 + kk * 32) * 2);
            acc = __builtin_amdgcn_mfma_f32_16x16x32_bf16(af, bf, acc, 0, 0, 0); }
        red[F.wid * 64 + F.lane] = acc;
        __syncthreads();
        if (F.wid == 0) { f32x4 o = red[F.lane];
#pragma unroll
            for (int w = 1; w < 8; ++w) o = o + red[w * 64 + F.lane];
#pragma unroll
            for (int r = 0; r < 4; ++r) c0[(size_t)(4 * fq + r) * D + nbk * 16 + fr] = o[r]; }
        __syncthreads();
    }
}
struct EpiF32 {
    static constexpr bool PERM = false; static constexpr bool KHOOK = false;
    float* C; int ldc;
    __device__ __forceinline__ void operator()(const f32x4 (&acc)[2][2][4][2], const pg8::Unit& u, int wr, int wc, int fr, int fq) const {
        const int row0 = u.pm * 256 + wr * 64 + fr, col0 = u.pn * 256 + wc * 32 + 4 * fq;
#pragma unroll
        for (int ai = 0; ai < 2; ++ai)
#pragma unroll
            for (int m = 0; m < 4; ++m) { float* rowp = C + (size_t)(row0 + ai * 128 + m * 16) * ldc + col0;
#pragma unroll
                for (int bj = 0; bj < 2; ++bj)
#pragma unroll
                    for (int n = 0; n < 2; ++n) *(f32x4*)(rowp + bj * 128 + n * 16) = acc[ai][bj][m][n]; }
    }
};

__device__ __forceinline__ void mix_hgrn2(const Ctx& F, const Params& p, int l, int it) {
    const int b = it >> 2, hd = it & 3;
    const bf16_t* proj = (const bf16_t*)(p.ws + WS_PROJ);
    bf16_t* ycat = (bf16_t*)(p.ws + WS_YCAT);
    const float* lbp = (const float*)(p.ws + WS_LB) + l * BW + hd * 128;
    LAS bf16_t* QH = (LAS bf16_t*)F.lds;
    LAS bf16_t* Q1 = QH + 32 * 136;
    LAS bf16_t* K0 = Q1 + 16 * 136;
    LAS bf16_t* KT = K0 + 16 * 136;
    LAS bf16_t* VT = KT + 128 * 40;
    LAS bf16_t* AM = VT + 128 * 40;
    LAS bf16_t* ST = AM + 32 * 40;
    LAS bf16_t* qsB = ST + 128 * 136;
    LAS bf16_t* kkB = qsB + 32 * 128;
    LAS float* bF = (LAS float*)(kkB + 32 * 128);
    LAS float* OS = bF + 32 * 128;
    LAS float* tot = OS + 32 * 132;
    const int d = F.tid & 127, tq = F.tid >> 7, ln = F.lane, l15 = ln & 15, lq = ln >> 4, w = F.wid;
    const float lb = lbp[d];
    __syncthreads();
    for (int i = F.tid; i < 128 * 136 / 8; i += 512) ((LAS u32x4*)ST)[i] = (u32x4){0u, 0u, 0u, 0u};
    f32x4 accS[8];
#pragma unroll
    for (int nt = 0; nt < 8; ++nt) accS[nt] = (f32x4){0.f, 0.f, 0.f, 0.f};
    unsigned rq[8], rf[8], rv[8];
    { const bf16_t* pr = proj + (size_t)(b * SEQ + tq * 8) * INC + hd * 128 + d;
#pragma unroll
      for (int i = 0; i < 8; ++i) { rq[i] = pr[(size_t)i * INC + 512]; rf[i] = pr[(size_t)i * INC + 1024]; rv[i] = pr[(size_t)i * INC + 1536]; } }
    float gnv[8];
    { const float* gn = p.hg_gain + l * BW + hd * 128 + (F.tid & 15) * 8;
#pragma unroll
      for (int j = 0; j < 8; ++j) gnv[j] = gn[j]; }
    for (int t0 = 0; t0 < SEQ; t0 += 32) {
        const u32x4 gv = *(const u32x4*)(proj + (size_t)(b * SEQ + t0 + (F.tid >> 4)) * INC + 2048 + hd * 128 + (F.tid & 15) * 8);
        float qs[8], kk[8], cs[8], fd[8]; unsigned vraw[8];
        { float run = 0.f;
#pragma unroll
          for (int i = 0; i < 8; ++i) { const float qv = bf2f(rq[i]), fv = bf2f(rf[i]); vraw[i] = rv[i];
              const float fg = lb + (1.0f - lb) * sigmoidf_(fv); fd[i] = fmaxf(fg, 1e-6f); run += __logf(fd[i]); cs[i] = run; kk[i] = 1.0f - fg; qs[i] = siluf_(qv); }
          tot[tq * 128 + d] = run;
          const int tn0 = (t0 + 32 < SEQ) ? t0 + 32 : t0; const bf16_t* pr = proj + (size_t)(b * SEQ + tn0 + tq * 8) * INC + hd * 128 + d;
#pragma unroll
          for (int i = 0; i < 8; ++i) { rq[i] = pr[(size_t)i * INC + 512]; rf[i] = pr[(size_t)i * INC + 1024]; rv[i] = pr[(size_t)i * INC + 1536]; } }
        __syncthreads();
        {   const float t0v = tot[d], t1v = tot[128 + d], t2v = tot[256 + d], t3v = tot[384 + d];
            const float ref1 = t0v + t1v, blast = ref1 + t2v + t3v, off = (tq > 0 ? t0v : 0.f) + (tq > 1 ? t1v : 0.f) + (tq > 2 ? t2v : 0.f);
            unsigned ktw[4];
#pragma unroll
            for (int i = 0; i < 8; ++i) { const int t = tq * 8 + i; const float bt = off + cs[i];
                bF[t * 128 + d] = fd[i]; qsB[t * 128 + d] = f2bf(qs[i]); kkB[t * 128 + d] = f2bf(kk[i]);
                QH[t * 136 + d] = f2bf(qs[i] * __expf(bt));
                const float kt = kk[i] * __expf(blast - bt);
                if (i & 1) ktw[i >> 1] = cvt_pk_bf16(__uint_as_float(ktw[i >> 1]), kt); else ktw[i >> 1] = __float_as_uint(kt);
                if (tq >= 2) Q1[(t - 16) * 136 + d] = f2bf(qs[i] * __expf(bt - ref1)); else K0[t * 136 + d] = f2bf(kk[i] * __expf(ref1 - bt)); }
            *(LAS u32x4*)(KT + d * 40 + tq * 8) = (u32x4){ktw[0], ktw[1], ktw[2], ktw[3]};
            *(LAS u32x4*)(VT + d * 40 + tq * 8) = (u32x4){vraw[0] | (vraw[1] << 16), vraw[2] | (vraw[3] << 16), vraw[4] | (vraw[5] << 16), vraw[6] | (vraw[7] << 16)}; }
        __syncthreads();
#pragma unroll 1
        for (int rr = 0; rr < 4; ++rr) { const int sb = rr >> 1, tl = (rr & 1) ? 15 - w : w, t = sb * 16 + tl;
            const float q0 = bf2f(qsB[t * 128 + ln]), q1 = bf2f(qsB[t * 128 + 64 + ln]);
            float v[16]; float e0 = 1.f, e1 = 1.f;
#pragma unroll
            for (int sl = 15; sl >= 0; --sl) { const int s2 = sb * 16 + sl;
                if (sl <= tl) { v[sl] = q0 * bf2f(kkB[s2 * 128 + ln]) * e0 + q1 * bf2f(kkB[s2 * 128 + 64 + ln]) * e1; e0 *= bF[s2 * 128 + ln]; e1 *= bF[s2 * 128 + 64 + ln]; }
                else v[sl] = 0.f; }
            const bool c5 = ln & 32, c4 = ln & 16, c3 = ln & 8, c2 = ln & 4;
            float v8[8], v4[4], v2[2], v1;
#pragma unroll
            for (int i = 0; i < 8; ++i) { const float snd = c5 ? v[i] : v[i + 8]; const float rcv = __shfl_xor(snd, 32); v8[i] = (c5 ? v[i + 8] : v[i]) + rcv; }
#pragma unroll
            for (int i = 0; i < 4; ++i) { const float snd = c4 ? v8[i] : v8[i + 4]; const float rcv = __shfl_xor(snd, 16); v4[i] = (c4 ? v8[i + 4] : v8[i]) + rcv; }
#pragma unroll
            for (int i = 0; i < 2; ++i) { const float snd = c3 ? v4[i] : v4[i + 2]; const float rcv = __shfl_xor(snd, 8); v2[i] = (c3 ? v4[i + 2] : v4[i]) + rcv; }
            { const float snd = c2 ? v2[0] : v2[1]; const float rcv = __shfl_xor(snd, 4); v1 = (c2 ? v2[1] : v2[0]) + rcv; }
            v1 += __shfl_xor(v1, 2); v1 += __shfl_xor(v1, 1);
            const int sl = ln >> 2;
            if ((ln & 3) == 0) AM[t * 40 + sb * 16 + sl] = f2bf(sl <= tl ? v1 : 0.f);
            else if ((ln & 3) == 1 && sb == 0) AM[t * 40 + 16 + sl] = (bf16_t)0; }
        if (w == 0) { f32x4 o10 = (f32x4){0.f, 0.f, 0.f, 0.f};
#pragma unroll
            for (int ks = 0; ks < 4; ++ks) { const bf16x8 a = *(const LAS bf16x8*)(Q1 + l15 * 136 + 32 * ks + 8 * lq), bb = *(const LAS bf16x8*)(K0 + l15 * 136 + 32 * ks + 8 * lq); o10 = __builtin_amdgcn_mfma_f32_16x16x32_bf16(a, bb, o10, 0, 0, 0); }
#pragma unroll
            for (int r = 0; r < 4; ++r) AM[(16 + 4 * lq + r) * 40 + l15] = f2bf(o10[r]); }
        __syncthreads();
        const int mt = w & 1, np = w >> 1;
        f32x4 ao[2];
#pragma unroll
        for (int nt = 0; nt < 2; ++nt) { ao[nt] = (f32x4){0.f, 0.f, 0.f, 0.f}; const int en = 16 * (2 * np + nt) + l15;
#pragma unroll
            for (int ks = 0; ks < 4; ++ks) { const bf16x8 a = *(const LAS bf16x8*)(QH + (16 * mt + l15) * 136 + 32 * ks + 8 * lq), bb = *(const LAS bf16x8*)(ST + en * 136 + 32 * ks + 8 * lq); ao[nt] = __builtin_amdgcn_mfma_f32_16x16x32_bf16(a, bb, ao[nt], 0, 0, 0); }
            const bf16x8 a2 = *(const LAS bf16x8*)(AM + (16 * mt + l15) * 40 + 8 * lq), b2 = *(const LAS bf16x8*)(VT + en * 40 + 8 * lq); ao[nt] = __builtin_amdgcn_mfma_f32_16x16x32_bf16(a2, b2, ao[nt], 0, 0, 0); }
        {   float dec[4];
#pragma unroll
            for (int r = 0; r < 4; ++r) { const int dd = 16 * w + 4 * lq + r; dec[r] = __expf(tot[dd] + tot[128 + dd] + tot[256 + dd] + tot[384 + dd]); }
            const bf16x8 a3 = *(const LAS bf16x8*)(KT + (16 * w + l15) * 40 + 8 * lq);
#pragma unroll
            for (int nt = 0; nt < 8; ++nt) { f32x4 c = accS[nt];
#pragma unroll
                for (int r = 0; r < 4; ++r) c[r] *= dec[r];
                const bf16x8 b3 = *(const LAS bf16x8*)(VT + (16 * nt + l15) * 40 + 8 * lq); accS[nt] = __builtin_amdgcn_mfma_f32_16x16x32_bf16(a3, b3, c, 0, 0, 0); } }
        __syncthreads();
#pragma unroll
        for (int nt = 0; nt < 8; ++nt)
#pragma unroll
            for (int r = 0; r < 4; ++r) ST[(16 * nt + l15) * 136 + 16 * w + 4 * lq + r] = f2bf(accS[nt][r]);
#pragma unroll
        for (int nt = 0; nt < 2; ++nt)
#pragma unroll
            for (int r = 0; r < 4; ++r) OS[(16 * mt + 4 * lq + r) * 132 + 16 * (2 * np + nt) + l15] = ao[nt][r];
        __syncthreads();
        {   const int t = F.tid >> 4, e0 = (F.tid & 15) * 8; float o[8]; float ss = 0.f;
#pragma unroll
            for (int j = 0; j < 8; ++j) { o[j] = OS[t * 132 + e0 + j]; ss += o[j] * o[j]; }
            ss += __shfl_xor(ss, 1); ss += __shfl_xor(ss, 2); ss += __shfl_xor(ss, 4); ss += __shfl_xor(ss, 8);
            const float rs = rsqrtf(ss * (1.0f / 128.0f) + EPS);
            const size_t row = (size_t)(b * SEQ + t0 + t);
            float r[8];
#pragma unroll
            for (int j = 0; j < 8; ++j) { const float gg = (j & 1) ? bfhi(gv[j >> 1]) : bflo(gv[j >> 1]); r[j] = o[j] * rs * gnv[j] * siluf_(gg); }
            *(u32x4*)(ycat + row * D + 512 + hd * 128 + e0) = (u32x4){cvt_pk_bf16(r[0], r[1]), cvt_pk_bf16(r[2], r[3]), cvt_pk_bf16(r[4], r[5]), cvt_pk_bf16(r[6], r[7])};
        }
    }
}
__device__ __forceinline__ void mix_sb(const Ctx& F, const Params& p, int it) {
    const int qb = 15 - (it >> 6), bh = it & 63, b = bh >> 2, hd = bh & 3;
    const bf16_t* proj = (const bf16_t*)(p.ws + WS_PROJ);
    bf16_t* ycat = (bf16_t*)(p.ws + WS_YCAT);
    constexpr int KP = 136, VP = 72, SP = 72;
    LAS bf16_t* Kt = (LAS bf16_t*)F.lds;
    LAS bf16_t* Vt = Kt + 64 * KP;
    LAS bf16_t* Ws = Vt + 128 * VP + F.wid * (3 * 16 * SP);
    const int ln = F.lane, l15 = ln & 15, lq = ln >> 4;
    const int trow0 = qb * 128 + F.wid * 16;
    bf16x8 qa[4];
    { const bf16_t* qp = proj + (size_t)(b * SEQ + trow0 + l15) * INC + 2560 + hd * 128 + 8 * lq;
#pragma unroll
      for (int ks = 0; ks < 4; ++ks) qa[ks] = *(const bf16x8*)(qp + 32 * ks); }
    bf16x8 uA, uB, uOne;
#pragma unroll
    for (int j = 0; j < 8; ++j) { const int kk = 8 * lq + j; uA[j] = (kk > l15) ? (short)0x3F80 : (short)0; uB[j] = (kk > 16 + l15) ? (short)0x3F80 : (short)0; uOne[j] = (short)0x3F80; }
    f32x4 O[8];
#pragma unroll
    for (int nt = 0; nt < 8; ++nt) O[nt] = (f32x4){0.f, 0.f, 0.f, 0.f};
    float run[4] = {0.f, 0.f, 0.f, 0.f};
    for (int kt = qb * 2 + 1; kt >= 0; --kt) {
        __syncthreads();
#pragma unroll
        for (int c2 = 0; c2 < 2; ++c2) { const int c = F.tid + 512 * c2, row = c >> 4, c8 = (c & 15) * 8; const size_t rb = (size_t)(b * SEQ + kt * 64 + row) * INC + hd * 128 + c8;
            const u32x4 kw = *(const u32x4*)(proj + rb + 3072), vw = *(const u32x4*)(proj + rb + 3584);
            *(LAS u32x4*)(Kt + row * KP + c8) = kw;
#pragma unroll
            for (int j = 0; j < 4; ++j) { Vt[(c8 + 2 * j) * VP + row] = (bf16_t)(vw[j] & 0xffffu); Vt[(c8 + 2 * j + 1) * VP + row] = (bf16_t)(vw[j] >> 16); } }
        __syncthreads();
        f32x4 z[4];
#pragma unroll
        for (int nt = 0; nt < 4; ++nt) { z[nt] = (f32x4){0.f, 0.f, 0.f, 0.f};
#pragma unroll
            for (int ks = 0; ks < 4; ++ks) { const bf16x8 kf = *(const LAS bf16x8*)(Kt + (16 * nt + l15) * KP + 32 * ks + 8 * lq); z[nt] = __builtin_amdgcn_mfma_f32_16x16x32_bf16(qa[ks], kf, z[nt], 0, 0, 0); } }
        float lbv[4][4]; bool vld[4][4];
#pragma unroll
        for (int nt = 0; nt < 4; ++nt)
#pragma unroll
            for (int r = 0; r < 4; ++r) { const float zz = z[nt][r] * 0.08838834764831845f; const float sp = fmaxf(zz, 0.f) + __logf(1.0f + __expf(-fabsf(zz)));
                const bool valid = (kt * 64 + 16 * nt + l15) < (trow0 + 4 * lq + r); vld[nt][r] = valid; lbv[nt][r] = zz - sp;
                const float lnv = valid ? -sp : 0.f; const unsigned hi = cvt_pk_bf16(lnv, 0.f) & 0xffffu; const float lo = lnv - __uint_as_float(hi << 16);
                Ws[(4 * lq + r) * SP + 16 * nt + l15] = (bf16_t)hi; Ws[(16 + 4 * lq + r) * SP + 16 * nt + l15] = f2bf(lo); }
        __syncthreads();
        bf16x8 ah[2], al[2];
#pragma unroll
        for (int ks = 0; ks < 2; ++ks) { ah[ks] = *(const LAS bf16x8*)(Ws + l15 * SP + 32 * ks + 8 * lq); al[ks] = *(const LAS bf16x8*)(Ws + (16 + l15) * SP + 32 * ks + 8 * lq); }
        f32x4 sfx[4], tot = (f32x4){0.f, 0.f, 0.f, 0.f};
#pragma unroll
        for (int nt = 0; nt < 4; ++nt) sfx[nt] = (f32x4){0.f, 0.f, 0.f, 0.f};
        sfx[0] = __builtin_amdgcn_mfma_f32_16x16x32_bf16(ah[0], uA, sfx[0], 0, 0, 0);   sfx[0] = __builtin_amdgcn_mfma_f32_16x16x32_bf16(al[0], uA, sfx[0], 0, 0, 0);
        sfx[1] = __builtin_amdgcn_mfma_f32_16x16x32_bf16(ah[0], uB, sfx[1], 0, 0, 0);   sfx[1] = __builtin_amdgcn_mfma_f32_16x16x32_bf16(al[0], uB, sfx[1], 0, 0, 0);
        sfx[0] = __builtin_amdgcn_mfma_f32_16x16x32_bf16(ah[1], uOne, sfx[0], 0, 0, 0); sfx[0] = __builtin_amdgcn_mfma_f32_16x16x32_bf16(al[1], uOne, sfx[0], 0, 0, 0);
        sfx[1] = __builtin_amdgcn_mfma_f32_16x16x32_bf16(ah[1], uOne, sfx[1], 0, 0, 0); sfx[1] = __builtin_amdgcn_mfma_f32_16x16x32_bf16(al[1], uOne, sfx[1], 0, 0, 0);
        sfx[2] = __builtin_amdgcn_mfma_f32_16x16x32_bf16(ah[1], uA, sfx[2], 0, 0, 0);   sfx[2] = __builtin_amdgcn_mfma_f32_16x16x32_bf16(al[1], uA, sfx[2], 0, 0, 0);
        sfx[3] = __builtin_amdgcn_mfma_f32_16x16x32_bf16(ah[1], uB, sfx[3], 0, 0, 0);   sfx[3] = __builtin_amdgcn_mfma_f32_16x16x32_bf16(al[1], uB, sfx[3], 0, 0, 0);
#pragma unroll
        for (int ks = 0; ks < 2; ++ks) { tot = __builtin_amdgcn_mfma_f32_16x16x32_bf16(ah[ks], uOne, tot, 0, 0, 0); tot = __builtin_amdgcn_mfma_f32_16x16x32_bf16(al[ks], uOne, tot, 0, 0, 0); }
#pragma unroll
        for (int nt = 0; nt < 4; ++nt)
#pragma unroll
            for (int r = 0; r < 4; ++r) { const float w = vld[nt][r] ? __expf(lbv[nt][r] + sfx[nt][r] + run[r]) : 0.f; Ws[(32 + 4 * lq + r) * SP + 16 * nt + l15] = f2bf(w); }
#pragma unroll
        for (int r = 0; r < 4; ++r) run[r] += tot[r];
        __syncthreads();
        bf16x8 wf[2];
#pragma unroll
        for (int ks = 0; ks < 2; ++ks) wf[ks] = *(const LAS bf16x8*)(Ws + (32 + l15) * SP + 32 * ks + 8 * lq);
#pragma unroll
        for (int nt = 0; nt < 8; ++nt)
#pragma unroll
            for (int ks = 0; ks < 2; ++ks) { const bf16x8 vf = *(const LAS bf16x8*)(Vt + (16 * nt + l15) * VP + 32 * ks + 8 * lq); O[nt] = __builtin_amdgcn_mfma_f32_16x16x32_bf16(wf[ks], vf, O[nt], 0, 0, 0); }
        {   const bool live = !(run[0] < -110.0f && run[1] < -110.0f && run[2] < -110.0f && run[3] < -110.0f);
            __syncthreads();
            if (F.tid == 0) F.misc[9] = 0u;
            __syncthreads();
            if (live) F.misc[9] = 1u;
            __syncthreads();
            if (F.misc[9] == 0u) break;
        }
    }
#pragma unroll
    for (int nt = 0; nt < 8; ++nt)
#pragma unroll
        for (int r = 0; r < 4; ++r) ycat[(size_t)(b * SEQ + trow0 + 4 * lq + r) * D + 1024 + hd * 128 + 16 * nt + l15] = f2bf(O[nt][r]);
}
__device__ __forceinline__ void mix_s5(const Ctx& F, const Params& p, int l, int it) {
    const int b = it >> 5, g = it & 31, w = F.wid, ln = F.lane, l15 = ln & 15, lq = ln >> 4;
    const bf16_t* proj = (const bf16_t*)(p.ws + WS_PROJ);
    bf16_t* yg = (bf16_t*)(p.ws + WS_YG);
    constexpr int BP = 132, XP = 136;
    LAS float* bu = (LAS float*)(F.lds + w * (16 * BP * 4 + 16 * XP * 2));
    LAS bf16_t* xs = (LAS bf16_t*)((LAS unsigned char*)bu + 16 * BP * 4);
    LAS float* ends = (LAS float*)(F.lds + MISC_OFF + 256);
    const float* sp = (const float*)(p.ws + WS_S5P) + (size_t)((l * 32 + g) * 64) * 36;
    const float are = sp[ln * 36], aim = sp[ln * 36 + 1];
    bf16x8 bfr[8];
#pragma unroll
    for (int nt = 0; nt < 8; ++nt) { const int col = 16 * nt + l15, pp = col & 63; const float* q = sp + pp * 36 + ((col >> 6) ? 20 : 4) + 8 * lq;
#pragma unroll
        for (int j = 0; j < 8; ++j) bfr[nt][j] = (lq < 2) ? (short)f2bf(q[j]) : (short)0; }
    bf16x8 cfr[4];
#pragma unroll
    for (int ks = 0; ks < 4; ++ks) { const int k0 = 32 * ks + 8 * lq; const float* cp = ((ks < 2) ? p.c_re : p.c_im) + (((size_t)l * 32 + g) * 16 + l15) * 64 + (k0 & 63);
#pragma unroll
        for (int j = 0; j < 8; ++j) cfr[ks][j] = (short)f2bf((ks < 2) ? cp[j] : -cp[j]); }
    const float dsk = p.s5_d[l * BW + g * 16 + l15];
    const bf16_t* ubase = proj + (size_t)(b * SEQ + w * 256) * INC + g * 16;
    float xr = 0.f, xi = 0.f;
    __syncthreads();
    const u32x4 zero4 = (u32x4){0u, 0u, 0u, 0u};
    u32x4 un = *(const u32x4*)(ubase + (size_t)l15 * INC + 8 * lq);
    for (int tb = 0; tb < 16; ++tb) {
        const bf16x8 ua = __builtin_bit_cast(bf16x8, (lq < 2) ? un : zero4);
        { const int tn = tb < 15 ? tb + 1 : 15; un = *(const u32x4*)(ubase + (size_t)(tn * 16 + l15) * INC + 8 * lq); }
#pragma unroll
        for (int nt = 0; nt < 8; ++nt) { f32x4 d = __builtin_amdgcn_mfma_f32_16x16x32_bf16(ua, bfr[nt], (f32x4){0.f, 0.f, 0.f, 0.f}, 0, 0, 0);
#pragma unroll
            for (int r = 0; r < 4; ++r) bu[(4 * lq + r) * BP + 16 * nt + l15] = d[r]; }
        __syncthreads();
#pragma unroll
        for (int t = 0; t < 16; ++t) { const float br = bu[t * BP + ln], bi = bu[t * BP + 64 + ln]; const float nr = are * xr - aim * xi + br, ni = are * xi + aim * xr + bi; xr = nr; xi = ni; }
    }
    ends[(w * 64 + ln) * 2] = xr; ends[(w * 64 + ln) * 2 + 1] = xi;
    float pr = are, pi = aim;
#pragma unroll
    for (int i = 0; i < 8; ++i) { const float nr = pr * pr - pi * pi, ni = 2.0f * pr * pi; pr = nr; pi = ni; }
    __syncthreads();
    xr = 0.f; xi = 0.f;
    for (int ww = 0; ww < w; ++ww) { const float er = ends[(ww * 64 + ln) * 2], ei = ends[(ww * 64 + ln) * 2 + 1]; const float nr = pr * xr - pi * xi + er, ni = pr * xi + pi * xr + ei; xr = nr; xi = ni; }
    un = *(const u32x4*)(ubase + (size_t)l15 * INC + 8 * lq);
    for (int tb = 0; tb < 16; ++tb) {
        const bf16x8 ua = __builtin_bit_cast(bf16x8, (lq < 2) ? un : zero4);
        { const int tn = tb < 15 ? tb + 1 : 15; un = *(const u32x4*)(ubase + (size_t)(tn * 16 + l15) * INC + 8 * lq); }
        bf16_t uq[4];
#pragma unroll
        for (int r = 0; r < 4; ++r) uq[r] = proj[(size_t)(b * SEQ + w * 256 + tb * 16 + 4 * lq + r) * INC + g * 16 + l15];
#pragma unroll
        for (int nt = 0; nt < 8; ++nt) { f32x4 d = __builtin_amdgcn_mfma_f32_16x16x32_bf16(ua, bfr[nt], (f32x4){0.f, 0.f, 0.f, 0.f}, 0, 0, 0);
#pragma unroll
            for (int r = 0; r < 4; ++r) bu[(4 * lq + r) * BP + 16 * nt + l15] = d[r]; }
        __syncthreads();
#pragma unroll
        for (int t = 0; t < 16; ++t) { const float br = bu[t * BP + ln], bi = bu[t * BP + 64 + ln]; const float nr = are * xr - aim * xi + br, ni = are * xi + aim * xr + bi; xr = nr; xi = ni;
            xs[t * XP + ln] = f2bf(xr); xs[t * XP + 64 + ln] = f2bf(xi); }
        __syncthreads();
        f32x4 y = (f32x4){0.f, 0.f, 0.f, 0.f};
#pragma unroll
        for (int ks = 0; ks < 4; ++ks) { const bf16x8 xa = *(const LAS bf16x8*)(xs + l15 * XP + 32 * ks + 8 * lq); y = __builtin_amdgcn_mfma_f32_16x16x32_bf16(xa, cfr[ks], y, 0, 0, 0); }
#pragma unroll
        for (int r = 0; r < 4; ++r) { const size_t row = (size_t)(b * SEQ + w * 256 + tb * 16 + 4 * lq + r); const float uu = bf2f(uq[r]);
            yg[row * BW + g * 16 + l15] = f2bf(gelu_erf(y[r] + dsk * uu)); }
    }
}
__device__ __forceinline__ void mix_pool(const Ctx& F, const Params& p, int it) {
    const int b = it >> 5, t0 = (it & 31) * 64, ch = F.tid, win = 2 << (ch >> 7);
    const bf16_t* pp = (const bf16_t*)(p.ws + WS_PROJ) + (size_t)b * SEQ * INC + 4096;
    bf16_t* po = (bf16_t*)(p.ws + WS_POOLED) + (size_t)b * SEQ * BW + ch;
    LAS bf16_t* ps = (LAS bf16_t*)F.lds;
    for (int i = F.tid; i < 79 * 64; i += 512) { const int r = i >> 6, c8 = (i & 63) * 8, t = t0 - 15 + r;
        u32x4 v = (u32x4){0u, 0u, 0u, 0u};
        if (t >= 0) v = *(const u32x4*)(pp + (size_t)t * INC + c8);
        *(LAS u32x4*)(ps + r * 512 + c8) = v; }
    __syncthreads();
    for (int tt = 0; tt < 64; ++tt) { const int t = t0 + tt; float s = 0.f;
        for (int j = 0; j < win; ++j) s += bf2f(ps[(tt + 15 - j) * 512 + ch]);
        const float cur = bf2f(ps[(tt + 15) * 512 + ch]); const int cnt = (t + 1) < win ? (t + 1) : win;
        po[(size_t)t * BW] = f2bf(s * __builtin_amdgcn_rcpf((float)cnt) - cur); }
}
constexpr int MIX_HG = 64, MIX_SB = 1024, MIX_S5 = 512, MIX_POOL = 512;
__device__ __forceinline__ void phase_mixers_long(const Ctx& F, const Params& p, int l) {
    for (int it = blockIdx.x; it < MIX_HG; it += F.G) mix_hgrn2(F, p, l, it);
}
__device__ __forceinline__ void phase_mixers_short(const Ctx& F, const Params& p, int l) {
    for (;;) {
        int it = next_item(F, 1 + l);
        if (it >= MIX_SB + MIX_S5 + MIX_POOL) break;
        if (it < MIX_SB) mix_sb(F, p, it);
        else if ((it -= MIX_SB) < MIX_S5) mix_s5(F, p, l, it);
        else mix_pool(F, p, it - MIX_S5);
    }
}

__device__ __forceinline__ unsigned sort_key(float v, unsigned tag, unsigned mask) { const unsigned u = __float_as_uint(v); const unsigned s = u ^ ((u >> 31) ? 0xffffffffu : 0x80000000u); return (s & ~mask) | tag; }
__device__ __forceinline__ float key_val(unsigned k, unsigned mask) { const unsigned s = (k & ~mask) | (mask >> 1); const unsigned u = s ^ ((s >> 31) ? 0x80000000u : 0xffffffffu); return __uint_as_float(u); }
__device__ __forceinline__ void key_insert(unsigned (&val)[16], unsigned cv) {
#pragma unroll
    for (int j = 0; j < 16; ++j) { const unsigned hi = max(val[j], cv), lo = min(val[j], cv); val[j] = hi; cv = lo; }
}
__device__ __forceinline__ unsigned dppq_xor1(unsigned x) { return (unsigned)__builtin_amdgcn_update_dpp(0, (int)x, 0xB1, 0xf, 0xf, true); }
__device__ __forceinline__ unsigned dppq_xor2(unsigned x) { return (unsigned)__builtin_amdgcn_update_dpp(0, (int)x, 0x4E, 0xf, 0xf, true); }
#define KCE(a, b) do { const unsigned hi_ = max(a, b), lo_ = min(a, b); a = hi_; b = lo_; } while (0)
__device__ __forceinline__ void bitonic_merge16(unsigned (&v)[16]) {
#pragma unroll
    for (int j = 8; j >= 1; j >>= 1)
#pragma unroll
        for (int i = 0; i < 16; ++i) if ((i & j) == 0) KCE(v[i], v[i | j]);
}
__device__ __forceinline__ void bitonic_sort16(unsigned (&v)[16]) {
#pragma unroll
    for (int k = 2; k <= 16; k <<= 1)
#pragma unroll
        for (int j = k >> 1; j >= 1; j >>= 1)
#pragma unroll
            for (int i = 0; i < 16; ++i) if ((i & j) == 0) { if ((i & k) == 0 || k == 16) KCE(v[i], v[i | j]); else KCE(v[i | j], v[i]); }
}
__device__ __forceinline__ void top16_merge(unsigned (&a)[16], const unsigned (&b)[16]) {
#pragma unroll
    for (int i = 0; i < 16; ++i) a[i] = max(a[i], b[15 - i]);
    bitonic_merge16(a);
}
__device__ __forceinline__ void phase_topk(const Ctx& F, const Params& p) {
    const bf16_t* scores = (const bf16_t*)(p.ws + WS_G8);
    int* eidx = (int*)(p.ws + WS_EIDX); float* gate = (float*)(p.ws + WS_GATE);
    LAS bf16_t* sc = (LAS bf16_t*)F.lds;
    const int part = F.tid & 1, half = (F.tid >> 1) & 1, hd = (F.tid >> 2) & 7, tl = F.tid >> 5;
    for (int it8 = blockIdx.x * 8; it8 < M / 16; it8 += F.G * 8)
#pragma unroll 1
    for (int it4 = it8; it4 < it8 + 8; it4 += 4) {
      unsigned s0[16], s1[16];
#pragma unroll
      for (int j = 0; j < 16; ++j) { s0[j] = 0u; s1[j] = 0u; }
#pragma unroll 1
      for (int sub = 0; sub < 4; ++sub) { const int it = it4 + sub;
        __syncthreads();
        { const u32x4* src = (const u32x4*)(scores + (size_t)it * 16 * D); LAS u32x4* dst = (LAS u32x4*)sc;
#pragma unroll
          for (int i = 0; i < 8; ++i) dst[i * 512 + F.tid] = __builtin_nontemporal_load(src + i * 512 + F.tid); }
        __syncthreads();
        unsigned k0[16];
        const LAS bf16_t* row = sc + tl * D + hd * 256 + half * 128 + part * 64;
        {
            unsigned ga[16], gb[16];
#pragma unroll
            for (int i = 0; i < 16; ++i) { const int idx = (i + F.tid) & 63; k0[i] = sort_key(bf2f(row[idx]), 127u - (unsigned)(part * 64 + idx), 127u); }
#pragma unroll
            for (int i = 0; i < 16; ++i) { const int idx = (16 + i + F.tid) & 63; ga[i] = sort_key(bf2f(row[idx]), 127u - (unsigned)(part * 64 + idx), 127u); }
            bitonic_sort16(k0); bitonic_sort16(ga); top16_merge(k0, ga);
#pragma unroll
            for (int i = 0; i < 16; ++i) { const int idx = (32 + i + F.tid) & 63; ga[i] = sort_key(bf2f(row[idx]), 127u - (unsigned)(part * 64 + idx), 127u); }
#pragma unroll
            for (int i = 0; i < 16; ++i) { const int idx = (48 + i + F.tid) & 63; gb[i] = sort_key(bf2f(row[idx]), 127u - (unsigned)(part * 64 + idx), 127u); }
            bitonic_sort16(ga); bitonic_sort16(gb); top16_merge(ga, gb); top16_merge(k0, ga);
        }
        { unsigned o[16];
#pragma unroll
          for (int j = 0; j < 16; ++j) o[j] = dppq_xor1(k0[j]);
          top16_merge(k0, o); }
        { const bool mine = (F.tid & 3) == sub;
#pragma unroll
          for (int j = 0; j < 16; ++j) { const unsigned k1 = dppq_xor2(k0[j]); const unsigned h0 = half ? k1 : k0[j], h1 = half ? k0[j] : k1;
              s0[j] = mine ? h0 : s0[j]; s1[j] = mine ? h1 : s1[j]; } }
      }
        __syncthreads();
        {   const int it = it4 + (F.tid & 3);
            LAS unsigned* kl = (LAS unsigned*)F.lds + F.tid * 33;
            float v0[16], v1[16];
#pragma unroll
            for (int j = 0; j < 16; ++j) { v0[j] = key_val(s0[j], 127u); v1[j] = key_val(s1[j], 127u); kl[j] = 127u - (s0[j] & 127u); kl[16 + j] = 127u - (s1[j] & 127u); }
            unsigned bk[16], ga[16], gb[16];
            {   int n = 0;
#pragma unroll
                for (int i = 0; i < 16; ++i)
#pragma unroll
                    for (int j = 0; j < 16; ++j) if ((i + 1) * (j + 1) <= 16) { const unsigned kv = sort_key(v0[i] + v1[j], 255u - (unsigned)(i * 16 + j), 255u);
                        if (n < 16) bk[n] = kv; else if (n < 32) ga[n - 16] = kv; else if (n < 48) gb[n - 32] = kv; ++n; }
            }
            bitonic_sort16(bk); bitonic_sort16(ga); top16_merge(bk, ga);
            {
                int n = 0;
#pragma unroll
                for (int q = 0; q < 16; ++q) ga[q] = 0u;
#pragma unroll
                for (int i = 0; i < 16; ++i)
#pragma unroll
                    for (int j = 0; j < 16; ++j) if ((i + 1) * (j + 1) <= 16) { if (n >= 48) ga[n - 48] = sort_key(v0[i] + v1[j], 255u - (unsigned)(i * 16 + j), 255u); ++n; }
            }
            bitonic_sort16(gb); bitonic_sort16(ga); top16_merge(gb, ga); top16_merge(bk, gb);
            float ex[16], sum = 0.f; const float top = key_val(bk[0], 255u);
#pragma unroll
            for (int j = 0; j < 16; ++j) { ex[j] = __expf(key_val(bk[j], 255u) - top); sum += ex[j]; }
            const float inv = 1.0f / sum;
            int bi[16];
#pragma unroll
            for (int j = 0; j < 16; ++j) { const unsigned pr = 255u - (bk[j] & 255u); bi[j] = (int)(kl[pr >> 4] * 128u + kl[16 + (pr & 15u)]); }
            const int t = it * 16 + tl;
            int* ep = eidx + (size_t)t * 128 + hd * 16; float* gp = gate + (size_t)t * 128 + hd * 16;
#pragma unroll
            for (int j = 0; j < 16; j += 4) { *(int4*)(ep + j) = make_int4(bi[j], bi[j + 1], bi[j + 2], bi[j + 3]); *(f32x4*)(gp + j) = (f32x4){ex[j] * inv, ex[j + 1] * inv, ex[j + 2] * inv, ex[j + 3] * inv}; }
        }
    }
}
__device__ __forceinline__ float dot16_fp8(const f32x2 (&h2)[8], const u32x4 r) {
    f32x2 z = (f32x2){0.f, 0.f};
#pragma unroll
    for (int w = 0; w < 4; ++w) { const f32x2 lo = __builtin_amdgcn_cvt_pk_f32_fp8((int)r[w], false), hi = __builtin_amdgcn_cvt_pk_f32_fp8((int)r[w], true);
        z = __builtin_elementwise_fma(h2[2 * w], lo, z); z = __builtin_elementwise_fma(h2[2 * w + 1], hi, z); }
    return z[0] + z[1];
}
#define PEER_GATHER(dst, esrc) do { _Pragma("unroll") for (int ii = 0; ii < 8; ++ii) { const int e_ = __shfl((esrc), 8 * ii + g); dst[ii] = *(const u32x4*)(T8 + (unsigned)(e_ * 128 + j * 16)); } } while (0)
__device__ __forceinline__ void peer_v_accum(const u32x4 (&r)[8], float wsrc, f32x2 (&ac2)[8], int g) {
#pragma unroll
    for (int ii = 0; ii < 8; ++ii) { const float wv = __shfl(wsrc, 8 * ii + g); const f32x2 ws2 = (f32x2){wv, wv};
#pragma unroll
        for (int w = 0; w < 4; ++w) { const f32x2 lo = __builtin_amdgcn_cvt_pk_f32_fp8((int)r[ii][w], false), hi = __builtin_amdgcn_cvt_pk_f32_fp8((int)r[ii][w], true);
            ac2[2 * w] = __builtin_elementwise_fma(ws2, lo, ac2[2 * w]); ac2[2 * w + 1] = __builtin_elementwise_fma(ws2, hi, ac2[2 * w + 1]); } }
}
__device__ __forceinline__ void peer_u_accum_lds(const u32x4 (&r)[8], const f32x2 (&h)[8], LAS float* zrow, int half, int g, int j, bool b0, bool b1, bool b2) {
    float pz[8];
#pragma unroll
    for (int ii = 0; ii < 8; ++ii) pz[ii] = dot16_fp8(h, r[ii]);
    float q4[4], q2[2];
#pragma unroll
    for (int i = 0; i < 4; ++i) { const float snd = b2 ? pz[i] : pz[i + 4]; const float rcv = __shfl_xor(snd, 4); q4[i] = (b2 ? pz[i + 4] : pz[i]) + rcv; }
#pragma unroll
    for (int i = 0; i < 2; ++i) { const float snd = b1 ? q4[i] : q4[i + 2]; const float rcv = __shfl_xor(snd, 2); q2[i] = (b1 ? q4[i + 2] : q4[i]) + rcv; }
    const float snd = b0 ? q2[0] : q2[1]; const float rcv = __shfl_xor(snd, 1); const float q1 = (b0 ? q2[1] : q2[0]) + rcv;
    zrow[8 * (half * 8 + j) + g] += q1;
}
__device__ __forceinline__ void phase_peer_fused(const Ctx& F, const Params& p, int l, float* xres) {
    const bf16_t* H = (const bf16_t*)(p.ws + WS_H);
    const int* eidx = (const int*)(p.ws + WS_EIDX); const float* gate = (const float*)(p.ws + WS_GATE);
    const float* su = (const float*)(p.ws + WS_SU) + l * NEXP; const float* sv = (const float*)(p.ws + WS_SV) + l * NEXP;
    const float* g2 = (const float*)(p.ws + WS_MOD) + (size_t)l * BATCH * ADA + 5 * D;
    const int g = F.lane >> 3, j = F.lane & 7; const bool b0 = F.lane & 1, b1 = F.lane & 2, b2 = F.lane & 4, b3 = F.lane & 8, b4 = F.lane & 16, b5 = F.lane & 32;
    LAS float* zl = (LAS float*)F.lds + F.wid * (16 * 128);
    for (int tile = blockIdx.x; tile < M / 128; tile += F.G) {
        const int t0 = tile * 128 + F.wid * 16, b = t0 / SEQ;
#pragma unroll
        for (int i = 0; i < 32; ++i) zl[i * 64 + F.lane] = 0.f;
        {   const unsigned char* T8b = p.ws + WS_PU8 + (size_t)l * 16 * NEXP * 128;
            const unsigned jo = (unsigned)(j * 16), lo_ = (unsigned)F.lane;
            u32x4 hw0 = *(const u32x4*)(H + (size_t)t0 * D + jo), hw1 = *(const u32x4*)(H + (size_t)t0 * D + 8 + jo); int e_a = (eidx + (size_t)t0 * 128)[lo_], e_b = (eidx + (size_t)t0 * 128 + 64)[lo_];
            u32x4 ra[8], rb[8];
            { const unsigned char* T8 = T8b; PEER_GATHER(ra, e_a); }
#pragma unroll 1
            for (int st = 0; st < 256; ++st) {
                const int s = st >> 4, tk = st & 15, sx = st < 255 ? st + 1 : st, sn = sx >> 4, tn = sx & 15;
                const bf16_t* hn = H + ((size_t)(t0 + tn) * D + sn * 128);
                const u32x4 nw0 = __builtin_nontemporal_load((const u32x4*)(hn + jo)), nw1 = __builtin_nontemporal_load((const u32x4*)(hn + 8 + jo)); const int* en = eidx + (size_t)(t0 + tn) * 128; const int ne_a = en[lo_], ne_b = (en + 64)[lo_];
                { const unsigned char* T8 = T8b + (size_t)s * NEXP * 128; PEER_GATHER(rb, e_b); }
                f32x2 h[8];
#pragma unroll
                for (int q = 0; q < 4; ++q) { h[q] = (f32x2){bflo(hw0[q]), bfhi(hw0[q])}; h[4 + q] = (f32x2){bflo(hw1[q]), bfhi(hw1[q])}; }
                peer_u_accum_lds(ra, h, zl + tk * 128, 0, g, j, b0, b1, b2);
                { const unsigned char* T8 = T8b + (size_t)sn * NEXP * 128; PEER_GATHER(ra, ne_a); }
                peer_u_accum_lds(rb, h, zl + tk * 128, 1, g, j, b0, b1, b2);
                hw0 = nw0; hw1 = nw1; e_a = ne_a; e_b = ne_b;
            }
        }
        __syncthreads();
#pragma unroll 4
        for (int tk = 0; tk < 16; ++tk) { const float rs = rsqrtf((float)((const unsigned long long*)(p.ws + WS_RSS))[t0 + tk] * (RSS_INV / D) + EPS);
#pragma unroll
            for (int hh = 0; hh < 2; ++hh) { const int k = hh * 64 + F.lane; const size_t gi = (size_t)(t0 + tk) * 128 + k; const int e = eidx[gi];
                zl[tk * 128 + k] = gate[gi] * gelu_erf((zl[tk * 128 + k] * rs + ((const float*)(p.ws + WS_SD))[(size_t)b * NEXP + e]) * su[e]) * sv[e]; } }
        __syncthreads();
        {   const unsigned char* T8b = p.ws + WS_PV8 + (size_t)l * 16 * NEXP * 128;
            const unsigned colj = (unsigned)(j * 16 + (b3 ? 8 : 0) + (b4 ? 4 : 0) + (b5 ? 2 : 0)), lo_ = (unsigned)F.lane;
            int e_a = (eidx + (size_t)t0 * 128)[lo_], e_b = (eidx + (size_t)t0 * 128 + 64)[lo_];
            u32x4 ra[8], rb[8];
            { const unsigned char* T8 = T8b; PEER_GATHER(ra, e_a); }
#pragma unroll 1
            for (int st = 0; st < 256; ++st) {
                const int s = st >> 4, tk = st & 15, sx = st < 255 ? st + 1 : st, sn = sx >> 4, tn = sx & 15;
                const int* en = eidx + (size_t)(t0 + tn) * 128; const int ne_a = en[lo_], ne_b = (en + 64)[lo_];
                const float w_a = zl[tk * 128 + F.lane], w_b = zl[tk * 128 + 64 + F.lane];
                const f32x2 gv = *(const f32x2*)(g2 + ((size_t)b * ADA + s * 128) + colj);
                float* xp = xres + ((size_t)(t0 + tk) * D + s * 128) + colj; const f32x2 xv = __builtin_nontemporal_load((const f32x2*)xp);
                { const unsigned char* T8 = T8b + (size_t)s * NEXP * 128; PEER_GATHER(rb, e_b); }
                f32x2 ac2[8];
#pragma unroll
                for (int c = 0; c < 8; ++c) ac2[c] = (f32x2){0.f, 0.f};
                peer_v_accum(ra, w_a, ac2, g);
                { const unsigned char* T8 = T8b + (size_t)sn * NEXP * 128; PEER_GATHER(ra, ne_a); }
                peer_v_accum(rb, w_b, ac2, g);
                float acc[16];
#pragma unroll
                for (int c = 0; c < 8; ++c) { acc[2 * c] = ac2[c][0]; acc[2 * c + 1] = ac2[c][1]; }
                float a8[8], a4[4], a2[2];
#pragma unroll
                for (int i = 0; i < 8; ++i) { const float snd = b3 ? acc[i] : acc[i + 8]; const float rcv = __shfl_xor(snd, 8); a8[i] = (b3 ? acc[i + 8] : acc[i]) + rcv; }
#pragma unroll
                for (int i = 0; i < 4; ++i) { const float snd = b4 ? a8[i] : a8[i + 4]; const float rcv = __shfl_xor(snd, 16); a4[i] = (b4 ? a8[i + 4] : a8[i]) + rcv; }
#pragma unroll
                for (int i = 0; i < 2; ++i) { const float snd = b5 ? a4[i] : a4[i + 2]; const float rcv = __shfl_xor(snd, 32); a2[i] = (b5 ? a4[i + 2] : a4[i]) + rcv; }
                __builtin_nontemporal_store((f32x2){xv[0] + gv[0] * a2[0], xv[1] + gv[1] * a2[1]}, (f32x2*)xp);
                e_a = ne_a; e_b = ne_b;
            }
        }
        asm volatile("s_waitcnt vmcnt(0)" ::: "memory");
        __builtin_amdgcn_fence(__ATOMIC_ACQUIRE, "agent");
        asm volatile("s_waitcnt vmcnt(0)" ::: "memory");
        if (l + 1 < DEPTH) { const float* mod1 = (const float*)(p.ws + WS_MOD) + (size_t)(l + 1) * BATCH * ADA; const float* gn = p.nmg + (l + 1) * D;
            asm volatile("" : "+s"(mod1), "+s"(gn));
#pragma unroll 1
            for (int tk = 0; tk < 16; tk += 4) norm_rows<0, 4>(F, t0 + tk, xres, gn, mod1, mod1 + D, (bf16_t*)(p.ws + WS_H), nullptr);
        } else { const float* gn = p.final_gain;
            asm volatile("" : "+s"(gn));
#pragma unroll 1
            for (int tk = 0; tk < 16; tk += 4) norm_rows<1, 4>(F, t0 + tk, xres, gn, nullptr, nullptr, nullptr, xres);
        }
    }
}
constexpr int PH_PER_LAYER = 11, N_PHASES = 1 + DEPTH * PH_PER_LAYER;
typedef const __attribute__((address_space(4))) Params* KParamPtr;
#if defined(__HIP_DEVICE_COMPILE__)
#define PARAMS() ({ KParamPtr k_ = (KParamPtr)__builtin_amdgcn_kernarg_segment_ptr(); asm volatile("" : "+s"(k_)); *k_; })
#else
#define PARAMS() (Params{})
#endif
#define MAKE_CTX(Fn) Ctx Fn; { Fn.lds = (LAS unsigned char*)lds_raw; Fn.misc = (volatile LAS unsigned*)(Fn.lds + MISC_OFF); int t_ = threadIdx.x; asm volatile("" : "+v"(t_)); Fn.tid = t_; Fn.lane = t_ & 63; Fn.wid = __builtin_amdgcn_readfirstlane(t_ >> 6); Fn.G = gridDim.x; Fn.ctl = (unsigned*)(p.ws + WS_CTL); }
#define PHASE_ENV const Params p = PARAMS(); unsigned char* ws = p.ws; bf16_t* Hb = (bf16_t*)(ws + WS_H); bf16_t* PROJ = (bf16_t*)(ws + WS_PROJ); unsigned char* G8 = ws + WS_G8; const float* mod = (const float*)(ws + WS_MOD) + (size_t)l_ * BATCH * ADA; const float* xin = (l_ == 0) ? p.x : p.out; MAKE_CTX(F); (void)Hb; (void)PROJ; (void)G8; (void)mod; (void)xin; (void)F
#define IN(k) (lo <= (k) && (k) < hi)
#define SEAM(k) do { if (IN((k) + 1)) { const Params pq = PARAMS(); XcdBarrier bar; bar.bar = (unsigned*)(pq.ws + WS_CTL); bar.x = xb_xcc_id(); bar.st = (volatile LAS unsigned*)((LAS unsigned char*)lds_raw + MISC_OFF); xcd_barrier(bar); } } while (0)
template <int l>
__device__ __forceinline__ void layer_phases(const int lo, const int hi) {
    extern __shared__ __attribute__((aligned(16))) unsigned char lds_raw[];
        const int pb = 1 + l * PH_PER_LAYER;
        const int l_ = l;
        if (l == 0 && IN(pb + 0)) { PHASE_ENV; const Ctx& Fp = F; phase_norm<0>(Fp, xin, p.nmg + l * D, mod, mod + D, Hb, nullptr); SEAM(pb + 0); }
        if (IN(pb + 1)) { PHASE_ENV; pg8::Gemm g{Hb, (const bf16_t*)(ws + WS_BCAT) + (size_t)l * NCAT * D, M, INC, D, D, D, 0, 0, 0}; pg8::StaticOrder S; S.init(M, INC, F.G, (int)blockIdx.x);
            EpiBf16 E{PROJ, INC, 0}; pg8::gemm_phase(F.lds, g, S, E); SEAM(pb + 1); }
        if (IN(pb + 2)) { PHASE_ENV; const Ctx& Fp = F; phase_mixers_long(Fp, p, l);
            __syncthreads();
            { pg8::Gemm g{Hb, (const bf16_t*)(ws + WS_BCAT) + ((size_t)l * NCAT + INC) * D, M, 4 * D, D, D, D, 0, 0, 0};
              pg8::LateOrder S; S.init(M, 4 * D, F.G, (int)blockIdx.x); if (F.G == 256) { S.nhg = 64; S.r0 = 13; S.ex = 4; } else { S.nhg = 0; S.r0 = (S.nwg + F.G - 1) / F.G; S.ex = 0; }
              EpiGateT E{G8}; pg8::gemm_phase(F.lds, g, S, E); }
            __syncthreads();
            phase_mixers_short(Fp, p, l);
            SEAM(pb + 2); }
        if (IN(pb + 3)) { PHASE_ENV;
            { pg8::Gemm g{(const bf16_t*)(ws + WS_YG), (const bf16_t*)(ws + WS_WGLUT) + (size_t)l * BW * BW, M, BW, BW, BW, BW, 0, 0, 0}; pg8::StaticOrder S; S.init(M, BW, F.G, (int)blockIdx.x);
              EpiGlu E{(const bf16_t*)(ws + WS_YG), p.b_glu + l * BW, (bf16_t*)(ws + WS_YCAT)}; pg8::gemm_phase(F.lds, g, S, E); }
            { pg8::Gemm g{(const bf16_t*)(ws + WS_POOLED), (const bf16_t*)(ws + WS_POOLT) + (size_t)l * BW * BW, M, BW, BW, BW, BW, 0, 0, 0}; pg8::StaticOrder S; S.init(M, BW, F.G, (int)blockIdx.x);
              EpiBf16 E{(bf16_t*)(ws + WS_YCAT), D, 1536}; pg8::gemm_phase(F.lds, g, S, E); }
            { const Ctx& Fp = F; aux_shift_tables(Fp, p, l); }
            SEAM(pb + 3); }
        if (IN(pb + 4)) { PHASE_ENV;
            { pg8::Gemm g{(const bf16_t*)(ws + WS_YCAT), (const bf16_t*)(ws + WS_WBT) + (size_t)l * D * D, M, D, D, D, D, 0, 0, 0}; pg8::StaticOrder S; S.init(M, D, F.G, (int)blockIdx.x); EpiMerge E{G8, PROJ}; pg8::gemm_phase(F.lds, g, S, E); }
            SEAM(pb + 4); }
        if (IN(pb + 5)) { PHASE_ENV; pg8::Gemm g{PROJ, (const bf16_t*)(ws + WS_WOT) + (size_t)l * D * D, M, D, D, D, D, 0, 0, 0}; pg8::StaticOrder S; S.init(M, D, F.G, (int)blockIdx.x);
            EpiResidN E{xin, mod + 2 * D, p.out, p.nfg + l * D, mod + 4 * D, Hb, (unsigned long long*)(ws + WS_RSS)}; pg8::gemm_phase(F.lds, g, S, E); SEAM(pb + 6); }
        if (IN(pb + 7)) { PHASE_ENV; pg8::Gemm g{Hb, (const bf16_t*)(ws + WS_WQT) + (size_t)l * D * D, M, D, D, D, D, 0, 0, 0}; pg8::StaticOrder S; S.init(M, D, F.G, (int)blockIdx.x);
            EpiScore E{(bf16_t*)(ws + WS_G8), (const unsigned long long*)(ws + WS_RSS), (const float*)(ws + WS_C0)}; pg8::gemm_phase(F.lds, g, S, E); SEAM(pb + 8); }
        if (IN(pb + 9)) { PHASE_ENV; const Ctx& Fp = F; phase_topk(Fp, p);
            asm volatile("s_waitcnt vmcnt(0)" ::: "memory"); __syncthreads(); __builtin_amdgcn_fence(__ATOMIC_ACQUIRE, "agent"); }
        if (IN(pb + 10)) { PHASE_ENV; const Ctx& Fp = F; phase_peer_fused(Fp, p, l, p.out); SEAM(pb + 10); }
    }
__global__ void __launch_bounds__(512, 2) mega(Params p_unused) {
    extern __shared__ __attribute__((aligned(16))) unsigned char lds_raw[];
    {   volatile LAS unsigned* misc0 = (volatile LAS unsigned*)((LAS unsigned char*)lds_raw + MISC_OFF);
        if (threadIdx.x < 16) misc0[threadIdx.x] = 0u;
        __syncthreads();
        if (N_LAUNCHES == 1) { const Params p0 = PARAMS(); (void)xcd_barrier_post((unsigned*)(p0.ws + WS_CTL), misc0); } }
    int lo, hi; { const Params p0 = PARAMS(); lo = p0.ph_lo; hi = p0.ph_hi; }
    { const int l_ = 0; if (IN(0)) { PHASE_ENV; const Ctx& Fp = F; phase_prologue(Fp, p); SEAM(0); } }
    layer_phases<0>(lo, hi);
    layer_phases<1>(lo, hi);
#undef IN
#undef SEAM
#undef PHASE_ENV
}

extern "C" void kernel_launch(void* const* d_in, const int* in_sizes, int n_in, void* d_out, int out_size, void* d_ws, size_t ws_size, hipStream_t stream) {
    static int grid = 0;
    if (grid == 0) {
        if (n_in != 29 || ws_size < WS_END) { fprintf(stderr, "kernel_launch: need 29 inputs and %zu bytes of workspace; got %d, %zu\n", (size_t)WS_END, n_in, ws_size); grid = -1; return; }
        int dev = 0, cus = 0, per_cu = 0;
        if (hipGetDevice(&dev) != hipSuccess || hipDeviceGetAttribute(&cus, hipDeviceAttributeMultiprocessorCount, dev) != hipSuccess) { grid = -1; return; }
        if (hipFuncSetAttribute((const void*)mega, hipFuncAttributeMaxDynamicSharedMemorySize, LDS_BYTES) != hipSuccess) { fprintf(stderr, "kernel_launch: hipFuncSetAttribute failed\n"); grid = -1; return; }
        if (hipOccupancyMaxActiveBlocksPerMultiprocessor(&per_cu, (const void*)mega, 512, LDS_BYTES) != hipSuccess || per_cu < 1) { fprintf(stderr, "kernel_launch: occupancy query says %d\n", per_cu); }
        (void)hipGetLastError();
        grid = cus;
    }
    if (grid < 0) return;
    (void)hipMemsetAsync((char*)d_ws + WS_CTL, 0, CTL_BYTES, stream);
    Params p{};
    const float** pp = (const float**)&p;
    for (int i = 0; i < 29; ++i) pp[i] = (const float*)d_in[i];
    p.out = (float*)d_out; p.ws = (unsigned char*)d_ws;
#if N_LAUNCHES == 1
    p.ph_lo = 0; p.ph_hi = N_PHASES;
    hipLaunchKernelGGL(mega, dim3(grid), dim3(512), LDS_BYTES, stream, p);
#else
    for (int k = 0; k < N_PHASES; ++k) { p.ph_lo = k; p.ph_hi = k + 1; hipLaunchKernelGGL(mega, dim3(grid), dim3(512), LDS_BYTES, stream, p); }
#endif
}
```

```cpp
#include <hip/hip_runtime.h>
#include <cstdio>
#include <cstdint>

#ifndef N_LAUNCHES
#define N_LAUNCHES 1
#endif

#define LAS __attribute__((address_space(3)))
typedef unsigned short bf16_t;
typedef short bf16x8 __attribute__((ext_vector_type(8)));
typedef float f32x4 __attribute__((ext_vector_type(4)));
typedef float f32x2 __attribute__((ext_vector_type(2)));
typedef unsigned u32x4 __attribute__((ext_vector_type(4)));
typedef unsigned u32x2 __attribute__((ext_vector_type(2)));

constexpr int D = 2048, BATCH = 16, SEQ = 2048, M = BATCH * SEQ, DEPTH = 2;
constexpr int BW = 512, INC = 4608, NCAT = INC + 4 * D  , ADA = 6 * D;
constexpr int NEXP = 16384;
constexpr float EPS = 1e-6f;

__device__ __forceinline__ float bf2f(unsigned v) { return __uint_as_float(v << 16); }
__device__ __forceinline__ float bflo(unsigned w) { return __uint_as_float(w << 16); }
__device__ __forceinline__ float bfhi(unsigned w) { return __uint_as_float(w & 0xffff0000u); }
typedef __bf16 bf16x2_t __attribute__((ext_vector_type(2)));
__device__ __forceinline__ unsigned cvt_pk_bf16(float lo, float hi) { const bf16x2_t v = __builtin_convertvector((f32x2){lo, hi}, bf16x2_t); return __builtin_bit_cast(unsigned, v); }
__device__ __forceinline__ bf16_t f2bf(float f) { return (bf16_t)(cvt_pk_bf16(f, 0.f) & 0xffffu); }
__device__ __forceinline__ float sigmoidf_(float x) { return __builtin_amdgcn_rcpf(1.0f + __expf(-x)); }
__device__ __forceinline__ float siluf_(float x) { return x * __builtin_amdgcn_rcpf(1.0f + __expf(-x)); }
__device__ __forceinline__ float gelu_erf(float x) { return 0.5f * x * (1.0f + erff(x * 0.70710678118654752f)); }

#define WAVE_SYNC() asm volatile("s_waitcnt lgkmcnt(0)" ::: "memory")

#ifndef PG8_USE_SP2
#define PG8_USE_SP2 true
#endif
namespace pg8 {
constexpr int BM = 256, BK = 64, HALF = 128, HTB = HALF * BK * 2, STAGE_BYTES = 8 * HTB, NXCD = 8, WGM = 8;
__host__ __device__ __forceinline__ int lds_byte(int r, int c) { const int st = (r >> 4) * 2 + (c >> 5), rr = r & 15, cc = c & 31, ob = rr * 64 + cc * 2; return st * 1024 + (ob ^ (((ob >> 9) & 1) << 5)); }
__host__ __device__ __forceinline__ void stage_rc(int b, int& R, int& C) { const int st = b / 1024, sb = b % 1024, swz = sb ^ (((sb >> 9) & 1) << 5); R = (st >> 1) * 16 + swz / 64; C = (st & 1) * 32 + (swz % 64) / 2; }
__host__ __device__ __forceinline__ int perm32(int rho) { const int n = rho >> 4, i = rho & 15; return 8 * (i >> 2) + 4 * n + (i & 3); }
struct Unit { int pm, pn, pz; };
struct Gemm { const bf16_t* A; const bf16_t* Bt; int M, N, K, lda, ldb, apn; size_t zA, zB; };
struct StaticOrder {
    int nM, nN, nwg, G, c;
    __host__ __device__ void init(int M_, int N_, int G_, int c_) { nM = M_ / BM; nN = N_ / BM; nwg = nM * nN; G = G_; c = c_; }
    __host__ __device__ bool next(int i, Unit& u) const { return decode((long)i * G + c, u); }
    __host__ __device__ bool decode(long L, Unit& u) const {
        if (L >= nwg) return false;
        int wgid = (int)L; { const int q = nwg / NXCD, r = nwg % NXCD, xcd = wgid % NXCD, off = wgid / NXCD; wgid = (xcd < r ? xcd * (q + 1) : r * (q + 1) + (xcd - r) * q) + off; }
        const int nig = WGM * nN, gid = wgid / nig, fm = gid * WGM, gsz = (nM - fm) < WGM ? (nM - fm) : WGM;
        u.pm = fm + ((wgid % nig) % gsz); u.pn = (wgid % nig) / gsz; u.pz = 0; return true;
    }
    __device__ __forceinline__ void a_ready(const Unit&) const {}
    __device__ __forceinline__ void done(const Unit&) const {}
};
struct LateOrder : StaticOrder {
    int nhg, r0, ex;
    __host__ __device__ bool next(int i, Unit& u) const {
        if (i < r0) return decode((long)i * G + c, u);
        if (c < nhg || i >= r0 + ex) return false;
        return decode((long)r0 * G + (long)(c - nhg) * ex + (i - r0), u);
    }
};
template <int NZ> struct ZInnerOrder : StaticOrder {
    __host__ __device__ bool next(int i, Unit& u) const { const bool ok = StaticOrder::next(i / NZ, u); u.pz = i % NZ; return ok; }
};
template <class Epi, class Sched, bool SP2 = PG8_USE_SP2>
__device__ __forceinline__ void gemm_phase(LAS unsigned char* lds, const Gemm g, const Sched& S, const Epi& E) {
    int tid_ = threadIdx.x; asm volatile("" : "+v"(tid_));
    const int tid = tid_, wid = __builtin_amdgcn_readfirstlane(tid >> 6), lane = tid & 63, wr = wid >> 2, wc = wid & 3, fr = lane & 15, fq = lane >> 4;
    const int K = g.K, nt = K / BK;
    unsigned voffA[2], voffB[2];
#pragma unroll
    for (int i = 0; i < 2; ++i) { int R, C; stage_rc(tid * 16 + i * 8192, R, C); const int Rb = Epi::PERM ? ((R & ~31) + perm32(R & 31)) : R;
        voffA[i] = (unsigned)(R * g.lda + C) * 2u; voffB[i] = (unsigned)(Rb * g.ldb + C) * 2u; }
    const size_t kstep = (size_t)(BK * 2);
    const size_t hstepA = (size_t)HALF * g.lda * 2, hstepB = (size_t)HALF * g.ldb * 2;
    const size_t tstepA = 2 * hstepA, tstepB = 2 * hstepB, pstepA = (size_t)g.apn * 2, zstepA = g.zA * 2, zstepB = g.zB * 2;
    const unsigned ldsw = (unsigned)wid * 1024u;
    const int aoff = lds_byte(wr * 64 + fr, fq * 8), boff = lds_byte(wc * 32 + fr, fq * 8);
#define PG8_SA(b, h) (((b) * 2 + (h)) * HTB)
#define PG8_SB(b, h) ((4 + (b) * 2 + (h)) * HTB)
#define PG8_STAGE(bufoff, gbase, voff) do { _Pragma("unroll") for (int _i = 0; _i < 2; ++_i) \
        __builtin_amdgcn_global_load_lds((const unsigned*)((const char*)(gbase) + (voff)[_i]), (LAS unsigned*)(lds + (bufoff) + ldsw + _i * 8192), 16, 0, 0); } while (0)
#define PG8_LDA(dst, b, h) do { _Pragma("unroll") for (int m = 0; m < 4; ++m) _Pragma("unroll") for (int k = 0; k < 2; ++k) dst[m][k] = *(const LAS bf16x8*)(lds + PG8_SA(b, h) + aoff + m * 2048 + k * 1024); } while (0)
#define PG8_LDB(dst, b, h) do { _Pragma("unroll") for (int n = 0; n < 2; ++n) _Pragma("unroll") for (int k = 0; k < 2; ++k) dst[n][k] = *(const LAS bf16x8*)(lds + PG8_SB(b, h) + boff + n * 2048 + k * 1024); } while (0)
#define PG8_MMA(ai, bj, At, Bt) do { __builtin_amdgcn_s_setprio(1); _Pragma("unroll") for (int m = 0; m < 4; ++m) _Pragma("unroll") for (int n = 0; n < 2; ++n) _Pragma("unroll") for (int k = 0; k < 2; ++k) \
        acc[ai][bj][m][n] = __builtin_amdgcn_mfma_f32_16x16x32_bf16(Bt[n][k], At[m][k], acc[ai][bj][m][n], 0, 0, 0); __builtin_amdgcn_s_setprio(0); } while (0)
#define PG8_WAIT_V(n) asm volatile("s_waitcnt vmcnt(" #n ")" ::: "memory")
#define PG8_WAIT_L(n) asm volatile("s_waitcnt lgkmcnt(" #n ")" ::: "memory")
#define PG8_BAR __builtin_amdgcn_s_barrier()
#define PG8_SCHED __builtin_amdgcn_sched_barrier(0)
    Unit cur, nxt; int ui = 0;
    if (!S.next(0, cur)) return;
    f32x4 acc[2][2][4][2];
#pragma unroll
    for (int a = 0; a < 2; ++a)
#pragma unroll
        for (int b = 0; b < 2; ++b)
#pragma unroll
            for (int m = 0; m < 4; ++m)
#pragma unroll
                for (int n = 0; n < 2; ++n) acc[a][b][m][n] = (f32x4){0.f, 0.f, 0.f, 0.f};
    bf16x8 At[4][2], B0[2][2], B1[2][2];
    const char* cA = (const char*)g.A + (size_t)cur.pm * tstepA + (size_t)cur.pn * pstepA + (size_t)cur.pz * zstepA; const char* cB = (const char*)g.Bt + (size_t)cur.pn * tstepB + (size_t)cur.pz * zstepB;
    S.a_ready(cur);
    if constexpr (SP2) {
        PG8_STAGE(PG8_SB(0, 0), cB, voffB); PG8_STAGE(PG8_SB(0, 1), cB + hstepB, voffB); PG8_STAGE(PG8_SA(0, 0), cA, voffA); PG8_STAGE(PG8_SA(0, 1), cA + hstepA, voffA);
        if (wr == 1) PG8_BAR;
        PG8_WAIT_V(2); PG8_BAR;
        PG8_STAGE(PG8_SB(1, 0), cB + kstep, voffB); PG8_STAGE(PG8_SA(1, 0), cA + kstep, voffA); PG8_STAGE(PG8_SB(1, 1), cB + hstepB + kstep, voffB);
        PG8_WAIT_V(6); PG8_BAR;
    } else {
    PG8_STAGE(PG8_SB(0, 0), cB, voffB); PG8_STAGE(PG8_SA(0, 0), cA, voffA); PG8_STAGE(PG8_SB(0, 1), cB + hstepB, voffB); PG8_STAGE(PG8_SA(0, 1), cA + hstepA, voffA);
    if (wr == 1) PG8_BAR;
    PG8_WAIT_V(4); PG8_BAR;
    PG8_STAGE(PG8_SB(1, 0), cB + kstep, voffB); PG8_STAGE(PG8_SA(1, 0), cA + kstep, voffA); PG8_STAGE(PG8_SB(1, 1), cB + hstepB + kstep, voffB);
    PG8_WAIT_V(6); PG8_BAR;
    }
    for (;;) {
        const bool has_next = S.next(ui + 1, nxt);
        const char* nA = has_next ? (const char*)g.A + (size_t)nxt.pm * tstepA + (size_t)nxt.pn * pstepA + (size_t)nxt.pz * zstepA : cA; const char* nB = has_next ? (const char*)g.Bt + (size_t)nxt.pn * tstepB + (size_t)nxt.pz * zstepB : cB;
        for (int t = 0; t < nt; t += 2) {
            const bool last = (t == nt - 2);
            const char* a1 = cA + (size_t)(t + 1) * kstep;
            const char* a2 = last ? nA : cA + (size_t)(t + 2) * kstep; const char* b2 = last ? nB : cB + (size_t)(t + 2) * kstep;
            const char* a3 = a2 + kstep; const char* b3 = b2 + kstep;
            if (last && has_next) S.a_ready(nxt);
            if constexpr (Epi::KHOOK) { if (t != 0 && (t & 7) == 0) E.khook(acc, cur, t >> 3, wr, wc, fr, fq); }
            if constexpr (SP2) {
            PG8_LDB(B0, 0, 0); PG8_LDB(B1, 0, 1); PG8_SCHED; PG8_LDA(At, 0, 0); PG8_STAGE(PG8_SA(1, 1), a1 + hstepA, voffA);
            PG8_WAIT_V(8); PG8_WAIT_L(0); PG8_BAR; PG8_MMA(0, 0, At, B0); PG8_MMA(0, 1, At, B1); PG8_BAR; PG8_SCHED;
            PG8_LDA(At, 0, 1); PG8_STAGE(PG8_SB(0, 0), b2, voffB); PG8_STAGE(PG8_SB(0, 1), b2 + hstepB, voffB); PG8_STAGE(PG8_SA(0, 0), a2, voffA);
            PG8_WAIT_V(8); PG8_WAIT_L(0); PG8_BAR; PG8_MMA(1, 0, At, B0); PG8_MMA(1, 1, At, B1); PG8_BAR; PG8_SCHED;
            PG8_LDB(B0, 1, 0); PG8_LDB(B1, 1, 1); PG8_SCHED; PG8_LDA(At, 1, 0); PG8_STAGE(PG8_SA(0, 1), a2 + hstepA, voffA);
            PG8_WAIT_V(8); PG8_WAIT_L(0); PG8_BAR; PG8_MMA(0, 0, At, B0); PG8_MMA(0, 1, At, B1); PG8_BAR; PG8_SCHED;
            PG8_LDA(At, 1, 1); PG8_STAGE(PG8_SB(1, 0), b3, voffB); PG8_STAGE(PG8_SB(1, 1), b3 + hstepB, voffB); PG8_STAGE(PG8_SA(1, 0), a3, voffA);
            PG8_WAIT_V(8); PG8_WAIT_L(0); PG8_BAR; PG8_MMA(1, 0, At, B0); PG8_MMA(1, 1, At, B1); PG8_BAR; PG8_SCHED;
            } else {
            PG8_LDB(B0, 0, 0); PG8_SCHED; PG8_LDA(At, 0, 0); PG8_STAGE(PG8_SA(1, 1), a1 + hstepA, voffA);
            PG8_WAIT_L(8); PG8_BAR; PG8_WAIT_L(0); PG8_MMA(0, 0, At, B0); PG8_BAR; PG8_SCHED;
            PG8_LDB(B1, 0, 1); PG8_STAGE(PG8_SB(0, 0), b2, voffB);
            PG8_BAR; PG8_WAIT_L(0); PG8_MMA(0, 1, At, B1); PG8_BAR;
            PG8_LDA(At, 0, 1); PG8_STAGE(PG8_SA(0, 0), a2, voffA);
            PG8_BAR; PG8_WAIT_L(0); PG8_MMA(1, 0, At, B0); PG8_BAR; PG8_SCHED;
            PG8_STAGE(PG8_SB(0, 1), b2 + hstepB, voffB);
            PG8_WAIT_V(6); PG8_BAR; PG8_MMA(1, 1, At, B1); PG8_BAR;
            PG8_LDB(B0, 1, 0); PG8_SCHED; PG8_LDA(At, 1, 0); PG8_STAGE(PG8_SA(0, 1), a2 + hstepA, voffA);
            PG8_WAIT_L(8); PG8_BAR; PG8_WAIT_L(0); PG8_MMA(0, 0, At, B0); PG8_BAR; PG8_SCHED;
            PG8_LDB(B1, 1, 1); PG8_STAGE(PG8_SB(1, 0), b3, voffB);
            PG8_BAR; PG8_WAIT_L(0); PG8_MMA(0, 1, At, B1); PG8_BAR;
            PG8_LDA(At, 1, 1); PG8_STAGE(PG8_SA(1, 0), a3, voffA);
            PG8_BAR; PG8_WAIT_L(0); PG8_MMA(1, 0, At, B0); PG8_BAR; PG8_SCHED;
            PG8_STAGE(PG8_SB(1, 1), b3 + hstepB, voffB);
            PG8_WAIT_V(6); PG8_BAR; PG8_MMA(1, 1, At, B1); PG8_BAR;
            }
        }
        E(acc, cur, wr, wc, fr, fq); S.done(cur);
        if (!has_next) break;
#pragma unroll
        for (int a = 0; a < 2; ++a)
#pragma unroll
            for (int b = 0; b < 2; ++b)
#pragma unroll
                for (int m = 0; m < 4; ++m)
#pragma unroll
                    for (int n = 0; n < 2; ++n) acc[a][b][m][n] = (f32x4){0.f, 0.f, 0.f, 0.f};
        cur = nxt; cA = nA; cB = nB; ++ui;
    }
    PG8_WAIT_V(0);
    if (wr == 0) PG8_BAR;
    PG8_BAR;
#undef PG8_SA
#undef PG8_SB
#undef PG8_STAGE
#undef PG8_LDA
#undef PG8_LDB
#undef PG8_MMA
#undef PG8_WAIT_V
#undef PG8_WAIT_L
#undef PG8_BAR
#undef PG8_SCHED
}
}

#define XB_TMO      128
#define XB_XCNT(j)  (256  + 64 * (j))
#define XB_XSUB(j)  (1280 + 64 * (j))
#define XB_XGEN(j)  (2304 + 64 * (j))
#define XB_TOP      3328
#define XB_TOPGEN   3392
#define XCD_BAR_WORDS 3456
#define XB_SPIN_CAP (1u << 20)
__device__ __forceinline__ unsigned xb_ld(unsigned* p)              { return __hip_atomic_load(p, __ATOMIC_RELAXED, __HIP_MEMORY_SCOPE_AGENT); }
__device__ __forceinline__ unsigned xb_add(unsigned* p, unsigned v) { return __hip_atomic_fetch_add(p, v, __ATOMIC_RELAXED, __HIP_MEMORY_SCOPE_AGENT); }
__device__ __forceinline__ unsigned xb_xcc_id() { return (unsigned)__builtin_amdgcn_s_getreg((3 << 11) | 20) & 0xFu; }
#define XB_SPIN(cond, bar) do { unsigned _sp = 0; while (cond) { __builtin_amdgcn_s_sleep(1); \
    if ((++_sp & 255u) == 0u) { if (xb_ld(&(bar)[XB_TMO])) break; if (_sp > XB_SPIN_CAP) { atomicAdd(&(bar)[XB_TMO], 1u); break; } } } } while (0)
struct XcdBarrier { unsigned* bar; unsigned x; volatile LAS unsigned* st; };
__device__ __forceinline__ XcdBarrier xcd_barrier_post(unsigned* bar, volatile LAS unsigned* st) {
    XcdBarrier b; b.bar = bar; b.x = xb_xcc_id(); b.st = st;
    if (threadIdx.x == 0) (void)xb_add(&bar[XB_XCNT(b.x)], 1u);
    return b;
}
__device__ __forceinline__ void xcd_barrier_complete(unsigned* bar, unsigned x, unsigned& nloc, unsigned& nx) {
    const unsigned G = gridDim.x * gridDim.y * gridDim.z;
    unsigned sum, cnt, mine, sp = 0u;
    for (;;) {
        sum = 0u; cnt = 0u; mine = 0u;
#pragma unroll
        for (unsigned j = 0; j < 16; ++j) { const unsigned c = xb_ld(&bar[XB_XCNT(j)]); sum += c; cnt += (c > 0u) ? 1u : 0u; mine = (j == x) ? c : mine; }
        if (sum == G) break;
        __builtin_amdgcn_s_sleep(1);
        if ((++sp & 255u) == 0u) { if (xb_ld(&bar[XB_TMO])) break; if (sp > XB_SPIN_CAP) { atomicAdd(&bar[XB_TMO], 1u); break; } }
    }
    nloc = mine > 0u ? mine : 1u; nx = cnt > 0u ? cnt : 1u;
}
__device__ __forceinline__ void xcd_barrier(const XcdBarrier& b) {
    asm volatile("s_waitcnt vmcnt(0)" ::: "memory");
    __syncthreads();
    if (threadIdx.x == 0) {
        unsigned* bar = b.bar;
        __builtin_amdgcn_s_waitcnt(0);
        unsigned nloc = b.st[0], nx = b.st[1];
        if (nloc == 0u) { xcd_barrier_complete(bar, b.x, nloc, nx); b.st[0] = nloc; b.st[1] = nx; }
        const unsigned old = xb_add(&bar[XB_XSUB(b.x)], 1u);
        const unsigned gen = old / nloc;
        if (old + 1u == (gen + 1u) * nloc) {
            __builtin_amdgcn_fence(__ATOMIC_RELEASE, "agent");
            asm volatile("s_waitcnt vmcnt(0)" ::: "memory");
            const unsigned og = xb_add(&bar[XB_TOP], 1u);
            const unsigned tg = og / nx;
            if (og + 1u == (tg + 1u) * nx) xb_add(&bar[XB_TOPGEN], 1u);
            else XB_SPIN(xb_ld(&bar[XB_TOPGEN]) == tg, bar);
            __builtin_amdgcn_fence(__ATOMIC_ACQUIRE, "agent");
            xb_add(&bar[XB_XGEN(b.x)], 1u);
            asm volatile("s_waitcnt vmcnt(0)" ::: "memory");
        } else {
            XB_SPIN(xb_ld(&bar[XB_XGEN(b.x)]) == gen, bar);
            __builtin_amdgcn_fence(__ATOMIC_ACQUIRE, "agent");
            asm volatile("s_waitcnt vmcnt(0)" ::: "memory");
        }
    }
    __syncthreads();
}

constexpr size_t al256(size_t x) { return (x + 255) & ~(size_t)255; }
constexpr size_t WS_CTL   = 0;
constexpr size_t CTL_BYTES = 64 * 1024;
constexpr size_t WS_MOD   = WS_CTL + CTL_BYTES;
constexpr size_t WS_S5P   = WS_MOD + al256((size_t)DEPTH * BATCH * ADA * 4);
constexpr size_t WS_LB    = WS_S5P + al256((size_t)DEPTH * 32 * 64 * 36 * 4);
constexpr size_t WS_BCAT  = WS_LB + al256((size_t)DEPTH * BW * 4);
constexpr size_t WS_WBT   = WS_BCAT + (size_t)DEPTH * NCAT * D * 2;
constexpr size_t WS_WOT   = WS_WBT + (size_t)DEPTH * 4 * D * BW * 2;
constexpr size_t WS_WQT   = WS_WOT + (size_t)DEPTH * D * D * 2;
constexpr size_t WS_WGLUT = WS_WQT + (size_t)DEPTH * D * D * 2;
constexpr size_t WS_POOLT = WS_WGLUT + (size_t)DEPTH * BW * BW * 2;
constexpr size_t WS_KEYST = WS_POOLT + (size_t)DEPTH * BW * BW * 2;
constexpr size_t WS_PU8   = WS_KEYST + (size_t)DEPTH * D * 256 * 2;
constexpr size_t WS_PV8   = WS_PU8 + (size_t)DEPTH * NEXP * D;
constexpr size_t WS_SU    = WS_PV8 + (size_t)DEPTH * NEXP * D;
constexpr size_t WS_SV    = WS_SU + (size_t)DEPTH * NEXP * 4;
constexpr size_t WS_H     = WS_SV + (size_t)DEPTH * NEXP * 4;
constexpr size_t WS_PROJ  = WS_H + (size_t)M * D * 2;
constexpr size_t WS_G8    = WS_PROJ + (size_t)M * INC * 2;
constexpr size_t WS_YG    = WS_G8 + (size_t)M * 4 * D;
constexpr size_t WS_POOLED= WS_YG + (size_t)M * BW * 2;
constexpr size_t WS_EIDX  = WS_POOLED + (size_t)M * BW * 2;
constexpr size_t WS_GATE  = WS_EIDX + (size_t)M * 128 * 4;
constexpr size_t WS_YCAT  = WS_GATE + (size_t)M * 128 * 4;
constexpr size_t WS_END   = WS_YCAT + (size_t)M * D * 2;
constexpr size_t WS_RSS   = WS_PROJ + (size_t)M * D * 2;
constexpr size_t WS_C0    = WS_RSS + (size_t)M * 8;
constexpr float RSS_SCALE = 16777216.0f, RSS_INV = 1.0f / 16777216.0f;
constexpr size_t WS_SD    = WS_C0 + (size_t)BATCH * D * 4;
static_assert(WS_SD + (size_t)BATCH * NEXP * 4 <= WS_PROJ + (size_t)M * INC * 2, "aux tables must fit in the tail of PROJ");

constexpr int LDS_BYTES = 147456, MISC_OFF = 131072;
constexpr int CTR_WORD0 = 4096;

struct Params {
    const float *x, *c, *ada_w, *ada_b, *nmg, *nfg, *w_in, *lam_re, *lam_im, *log_step, *b_re, *b_im, *c_re, *c_im, *s5_d, *w_glu, *b_glu,
                *lb_logits, *hg_gain, *pool_w, *pool_scale, *w_gate, *w_branch, *w_out, *wq, *sub_keys, *peer_u, *peer_v, *final_gain;
    float* out; unsigned char* ws; int ph_lo, ph_hi;
};

struct Ctx { LAS unsigned char* lds; volatile LAS unsigned* misc; int tid, lane, wid, G; unsigned* ctl; };

__device__ __forceinline__ Ctx fresh(const Ctx& F) { Ctx R = F; int t = threadIdx.x; asm volatile("" : "+v"(t)); R.tid = t; R.lane = t & 63; R.wid = __builtin_amdgcn_readfirstlane(t >> 6); return R; }
__device__ __forceinline__ int next_item(const Ctx& F, int ctr, unsigned inc = 1u) {
    __syncthreads();
    if (F.tid == 0) F.misc[8] = __hip_atomic_fetch_add(F.ctl + CTR_WORD0 + 64 * ctr, inc, __ATOMIC_RELAXED, __HIP_MEMORY_SCOPE_AGENT);
    __syncthreads();
    return (int)F.misc[8];
}

__device__ __forceinline__ void pro_mod(const Ctx& F, const Params& p, int it) {
    const int l = it / 48, cb = it % 48;
    LAS float* cond = (LAS float*)F.lds;
    for (int i = F.tid; i < BATCH * D; i += 512) { const int b = i / D, k = i % D; const float v = p.c[i]; cond[k * 16 + b] = siluf_(v); }
    __syncthreads();
    float acc[16][4];
#pragma unroll
    for (int b = 0; b < 16; ++b)
#pragma unroll
        for (int j = 0; j < 4; ++j) acc[b][j] = 0.f;
    const int col = cb * 256 + F.lane * 4;
    const float* wp = p.ada_w + (size_t)l * D * ADA + col;
    const int k0 = F.wid * 256;
#pragma unroll 4
    for (int kk = 0; kk < 256; ++kk) {
        const int k = k0 + kk;
        const f32x4 w = __builtin_nontemporal_load((const f32x4*)(wp + (size_t)k * ADA));
        const LAS f32x4* cp = (const LAS f32x4*)(cond + k * 16);
#pragma unroll
        for (int q = 0; q < 4; ++q) { const f32x4 cv = cp[q];
#pragma unroll
            for (int r = 0; r < 4; ++r)
#pragma unroll
                for (int j = 0; j < 4; ++j) acc[q * 4 + r][j] += cv[r] * w[j]; }
    }
    __syncthreads();
    LAS float* red = (LAS float*)F.lds;
#pragma unroll
    for (int b = 0; b < 16; ++b)
#pragma unroll
        for (int j = 0; j < 4; ++j) red[(F.wid * 16 + b) * 256 + F.lane * 4 + j] = acc[b][j];
    __syncthreads();
    for (int o = F.tid; o < 16 * 256; o += 512) { const int b = o / 256, cc = o % 256; float s = 0.f;
#pragma unroll
        for (int w = 0; w < 8; ++w) s += red[(w * 16 + b) * 256 + cc];
        const int n = cb * 256 + cc;
        ((float*)(p.ws + WS_MOD))[((size_t)l * BATCH + b) * ADA + n] = s + p.ada_b[(size_t)l * ADA + n]; }
}
__device__ __forceinline__ void pro_transpose_tile(const Ctx& F, const float* src, int N, bf16_t* dst, int ldd, int k0, int n0) {
    LAS float* tile = (LAS float*)F.lds;
#pragma unroll
    for (int ps = 0; ps < 4; ++ps) { const int row = ps * 32 + (F.tid >> 4), c4 = (F.tid & 15) * 4;
        const f32x4 v = __builtin_nontemporal_load((const f32x4*)(src + (size_t)(k0 + row) * N + n0 + c4));
        tile[row * 65 + c4 + 0] = v[0]; tile[row * 65 + c4 + 1] = v[1]; tile[row * 65 + c4 + 2] = v[2]; tile[row * 65 + c4 + 3] = v[3]; }
    __syncthreads();
    const int n = F.tid >> 3, ks = (F.tid & 7) * 16;
    unsigned w[8];
#pragma unroll
    for (int i = 0; i < 8; ++i) w[i] = cvt_pk_bf16(tile[(ks + 2 * i) * 65 + n], tile[(ks + 2 * i + 1) * 65 + n]);
    u32x4* dp = (u32x4*)(dst + (size_t)(n0 + n) * ldd + k0 + ks);
    dp[0] = (u32x4){w[0], w[1], w[2], w[3]}; dp[1] = (u32x4){w[4], w[5], w[6], w[7]};
}
constexpr int TT_WIN = 16 * 72, TT_GATE = 16 * 32, TT_BR = 4 * 32, TT_SQ = 16 * 32, TT_GLU = 4 * 8;
constexpr int TT_LAYER = TT_WIN + 4 * TT_GATE + 4 * TT_BR + TT_SQ + TT_GLU;
__device__ __forceinline__ void pro_transpose(const Ctx& F, const Params& p, int it) {
    const int l = it / TT_LAYER; int r = it % TT_LAYER;
    const float* src; int N; bf16_t* dst; int ldd; int ntn;
    if (r < TT_WIN) { src = p.w_in + (size_t)l * D * INC; N = INC; dst = (bf16_t*)(p.ws + WS_BCAT) + (size_t)l * NCAT * D; ldd = D; ntn = 72; }
    else if ((r -= TT_WIN) < 4 * TT_GATE) { const int j = r / TT_GATE; r %= TT_GATE; src = p.w_gate + ((size_t)l * 4 + j) * D * D; N = D; dst = (bf16_t*)(p.ws + WS_BCAT) + ((size_t)l * NCAT + INC + (size_t)j * D) * D; ldd = D; ntn = 32; }
    else if ((r -= 4 * TT_GATE) < 4 * TT_BR) { const int j = r / TT_BR; r %= TT_BR; src = p.w_branch + ((size_t)l * 4 + j) * BW * D; N = D; dst = (bf16_t*)(p.ws + WS_WBT) + (size_t)l * D * D + (size_t)j * BW; ldd = D; ntn = 32; }
    else if ((r -= 4 * TT_BR) < TT_SQ) { src = p.w_out + (size_t)l * D * D; N = D; dst = (bf16_t*)(p.ws + WS_WOT) + (size_t)l * D * D; ldd = D; ntn = 32; }
    else { r -= TT_SQ; src = p.w_glu + (size_t)l * BW * BW; N = BW; dst = (bf16_t*)(p.ws + WS_WGLUT) + (size_t)l * BW * BW; ldd = BW; ntn = 8; }
    const int tk = r / ntn, tn = r % ntn;
    pro_transpose_tile(F, src, N, dst, ldd, tk * 128, tn * 64);
}
__device__ __forceinline__ void pro_qk(const Ctx& F, const Params& p, int it) {
    const int l = it >> 9, r = it & 511, kb = r >> 4, hp = r & 15;
    LAS float* qs = (LAS float*)F.lds;
    LAS float* ks = qs + 64 * 132;
    const float* wq = p.wq + (size_t)l * D * D + (size_t)(kb * 64) * D + hp * 128;
    const float* ky = p.sub_keys + ((size_t)l * 16 + hp) * 128 * 128;
    for (int i = F.tid; i < 64 * 32; i += 512) { const int row = i >> 5, c4 = (i & 31) * 4; *(LAS f32x4*)(qs + row * 132 + c4) = __builtin_nontemporal_load((const f32x4*)(wq + (size_t)row * D + c4)); }
    for (int i = F.tid; i < 128 * 32; i += 512) { const int row = i >> 5, c4 = (i & 31) * 4; *(LAS f32x4*)(ks + row * 132 + c4) = *(const f32x4*)(ky + (size_t)row * 128 + c4); }
    __syncthreads();
    const int fr = F.lane & 15, fq = F.lane >> 4, kblk = F.wid & 3, nb0 = (F.wid >> 2) * 4;
    f32x4 acc[4];
#pragma unroll
    for (int nb = 0; nb < 4; ++nb) acc[nb] = (f32x4){0.f, 0.f, 0.f, 0.f};
#pragma unroll
    for (int kk = 0; kk < 4; ++kk) {
        const LAS float* ap = qs + (kblk * 16 + fr) * 132 + kk * 32 + fq * 8;
        const f32x4 a0 = *(const LAS f32x4*)ap, a1 = *(const LAS f32x4*)(ap + 4);
        const u32x4 aw = (u32x4){cvt_pk_bf16(a0[0], a0[1]), cvt_pk_bf16(a0[2], a0[3]), cvt_pk_bf16(a1[0], a1[1]), cvt_pk_bf16(a1[2], a1[3])};
#pragma unroll
        for (int nb = 0; nb < 4; ++nb) {
            const LAS float* bp = ks + ((nb0 + nb) * 16 + fr) * 132 + kk * 32 + fq * 8;
            const f32x4 b0 = *(const LAS f32x4*)bp, b1 = *(const LAS f32x4*)(bp + 4);
            const u32x4 bw = (u32x4){cvt_pk_bf16(b0[0], b0[1]), cvt_pk_bf16(b0[2], b0[3]), cvt_pk_bf16(b1[0], b1[1]), cvt_pk_bf16(b1[2], b1[3])};
            acc[nb] = __builtin_amdgcn_mfma_f32_16x16x32_bf16(__builtin_bit_cast(bf16x8, aw), __builtin_bit_cast(bf16x8, bw), acc[nb], 0, 0, 0); } }
#pragma unroll
    for (int nb = 0; nb < 4; ++nb) {
        bf16_t* dst = (bf16_t*)(p.ws + WS_WQT) + ((size_t)l * D + hp * 128 + (nb0 + nb) * 16 + fr) * D + kb * 64 + kblk * 16 + 4 * fq;
        *(u32x2*)dst = (u32x2){cvt_pk_bf16(acc[nb][0], acc[nb][1]), cvt_pk_bf16(acc[nb][2], acc[nb][3])}; }
}
__device__ __forceinline__ void pro_small(const Ctx& F, const Params& p, int it) {
    if (it < 1024) {
        const int o = it * 512 + F.tid, l = o >> 18, r = o & 262143, n = r >> 9, k = r & 511, g = n >> 7, d = n & 127, g2 = k >> 7, c = k & 127;
        const float v = (g == g2) ? p.pool_w[(((size_t)l * 4 + g) * 128 + c) * 128 + d] * p.pool_scale[l * BW + n] : 0.f;
        ((bf16_t*)(p.ws + WS_POOLT))[o] = f2bf(v);
    } else if (it < 1024 + 2048) {
    } else if (it < 1024 + 2048 + 8) {
        const int o = (it - 3072) * 512 + F.tid, l = o >> 11, g = (o >> 6) & 31;
        const float lr = fminf(p.lam_re[o], -1e-4f), li = p.lam_im[o], step = expf(p.log_step[l * 32 + g]);
        const float mag = expf(lr * step); float sn, cs; sincosf(li * step, &sn, &cs);
        const float are = mag * cs, aim = mag * sn, den = lr * lr + li * li, nr = are - 1.0f;
        const float fr = (nr * lr + aim * li) / den, fi = (aim * lr - nr * li) / den;
        float* q = (float*)(p.ws + WS_S5P) + (size_t)o * 36;
        q[0] = are; q[1] = aim; q[2] = 0.f; q[3] = 0.f;
#pragma unroll
        for (int h = 0; h < 16; ++h) { const float br = p.b_re[(size_t)o * 16 + h], bi = p.b_im[(size_t)o * 16 + h]; q[4 + h] = fr * br - fi * bi; q[20 + h] = fr * bi + fi * br; }
    } else {
        const int o = (it - 3080) * 512 + F.tid, l = o >> 9, j = o & 511;
        const float a0 = p.lb_logits[j], a1 = p.lb_logits[BW + j];
        ((float*)(p.ws + WS_LB))[o] = (l == 0) ? 0.f : 1.0f / (1.0f + expf(a0 - a1));
    }
}
__device__ __forceinline__ void pro_peer(const Ctx& F, const Params& p, int it) {
    const int row = it * 8 + F.wid, tb = row >> 15, le = row & 32767, l = le >> 14, e = le & 16383;
    const float* src = (tb ? p.peer_v : p.peer_u) + (size_t)le * D;
    f32x4 v[8]; float am = 0.f;
#pragma unroll
    for (int i = 0; i < 4; ++i) { v[2 * i] = __builtin_nontemporal_load((const f32x4*)(src + i * 512 + F.lane * 8)); v[2 * i + 1] = __builtin_nontemporal_load((const f32x4*)(src + i * 512 + F.lane * 8 + 4)); }
#pragma unroll
    for (int i = 0; i < 8; ++i) am = fmaxf(fmaxf(am, fmaxf(fabsf(v[i][0]), fabsf(v[i][1]))), fmaxf(fabsf(v[i][2]), fabsf(v[i][3])));
#pragma unroll
    for (int o = 32; o >= 1; o >>= 1) am = fmaxf(am, __shfl_xor(am, o));
    const float scale = am > 0.f ? am * (1.0f / 440.0f) : 1.0f, inv = 1.0f / scale;
    unsigned char* T8 = p.ws + (tb ? WS_PV8 : WS_PU8) + (size_t)l * 16 * NEXP * 128;
#pragma unroll
    for (int i = 0; i < 4; ++i) { const int slice = 4 * i + (F.lane >> 4), off = (F.lane & 15) * 8; int w0 = 0, w1 = 0;
        w0 = __builtin_amdgcn_cvt_pk_fp8_f32(v[2 * i][0] * inv, v[2 * i][1] * inv, w0, false); w0 = __builtin_amdgcn_cvt_pk_fp8_f32(v[2 * i][2] * inv, v[2 * i][3] * inv, w0, true);
        w1 = __builtin_amdgcn_cvt_pk_fp8_f32(v[2 * i + 1][0] * inv, v[2 * i + 1][1] * inv, w1, false); w1 = __builtin_amdgcn_cvt_pk_fp8_f32(v[2 * i + 1][2] * inv, v[2 * i + 1][3] * inv, w1, true);
        *(u32x2*)(T8 + ((size_t)slice * NEXP + e) * 128 + off) = (u32x2){(unsigned)w0, (unsigned)w1}; }
    if (F.lane == 0) ((float*)(p.ws + (tb ? WS_SV : WS_SU)))[le] = scale;
}
constexpr int PRO_MOD = 96, PRO_TT = 2 * TT_LAYER, PRO_SMALL = 1024 + 2048 + 8 + 2, PRO_PEER = 2 * DEPTH * NEXP / 8, PRO_QK = DEPTH * 512;
__device__ __forceinline__ void phase_prologue(const Ctx& F, const Params& p) {
    for (;;) { const int it = next_item(F, 0); if (it >= PRO_MOD) break; pro_mod(F, p, it); }
    constexpr int PRO_REST = PRO_QK + PRO_TT + PRO_SMALL + PRO_PEER;
    for (;;) {
        const int base = next_item(F, 3, 4u);
        if (base >= PRO_REST) break;
#pragma unroll 1
        for (int q = 0; q < 4; ++q) { int it = base + q; if (it >= PRO_REST) break;
            __syncthreads();
            if (it < PRO_QK) pro_qk(F, p, it);
            else if ((it -= PRO_QK) < PRO_TT) pro_transpose(F, p, it);
            else if ((it -= PRO_TT) < PRO_SMALL) pro_small(F, p, it);
            else pro_peer(F, p, it - PRO_SMALL); }
    }
}

template <int MODE>
__device__ __forceinline__ void norm_row(const Ctx& F, int r, const float* xin, const float* gain, const float* sh, const float* sc, bf16_t* hout, float* fout) {
    {
        const int b = r / SEQ;
        const f32x4* xp = (const f32x4*)(xin + (size_t)r * D);
        f32x4 v[8]; float ss = 0.f;
#pragma unroll
        for (int i = 0; i < 8; ++i) { v[i] = xp[i * 64 + F.lane]; ss += v[i][0] * v[i][0] + v[i][1] * v[i][1] + v[i][2] * v[i][2] + v[i][3] * v[i][3]; }
#pragma unroll
        for (int o = 32; o >= 1; o >>= 1) ss += __shfl_xor(ss, o);
        const float rs = rsqrtf(ss * (1.0f / D) + EPS);
#pragma unroll
        for (int i = 0; i < 8; ++i) { const int c = (i * 64 + F.lane) * 4; const f32x4 g = *(const f32x4*)(gain + c); f32x4 y = v[i] * rs * g;
            if (MODE == 0) { const f32x4 s1 = *(const f32x4*)(sc + (size_t)b * ADA + c), s0 = *(const f32x4*)(sh + (size_t)b * ADA + c); y = y * (s1 + 1.0f) + s0;
                *(u32x2*)(hout + (size_t)r * D + c) = (u32x2){cvt_pk_bf16(y[0], y[1]), cvt_pk_bf16(y[2], y[3])}; }
            else *(f32x4*)(fout + (size_t)r * D + c) = y; }
    }
}
template <int MODE, int NR>
__device__ __forceinline__ void norm_rows(const Ctx& F, int r, const float* xin, const float* gain, const float* sh, const float* sc, bf16_t* hout, float* fout) {
    const int b = r / SEQ;
    const f32x4* xp = (const f32x4*)(xin + (size_t)r * D);
    f32x4 v[NR][8]; float ss[NR];
#pragma unroll
    for (int i = 0; i < 8; ++i)
#pragma unroll
        for (int q = 0; q < NR; ++q) v[q][i] = xp[q * (D / 4) + i * 64 + F.lane];
#pragma unroll
    for (int q = 0; q < NR; ++q) { float a = 0.f;
#pragma unroll
        for (int i = 0; i < 8; ++i) a += v[q][i][0] * v[q][i][0] + v[q][i][1] * v[q][i][1] + v[q][i][2] * v[q][i][2] + v[q][i][3] * v[q][i][3];
        ss[q] = a; }
#pragma unroll
    for (int o = 32; o >= 1; o >>= 1)
#pragma unroll
        for (int q = 0; q < NR; ++q) ss[q] += __shfl_xor(ss[q], o);
#pragma unroll
    for (int q = 0; q < NR; ++q) ss[q] = rsqrtf(ss[q] * (1.0f / D) + EPS);
#pragma unroll
    for (int i = 0; i < 8; ++i) { const int c = (i * 64 + F.lane) * 4; const f32x4 g = *(const f32x4*)(gain + c);
        f32x4 s1, s0; if (MODE == 0) { s1 = *(const f32x4*)(sc + (size_t)b * ADA + c) + 1.0f; s0 = *(const f32x4*)(sh + (size_t)b * ADA + c); }
#pragma unroll
        for (int q = 0; q < NR; ++q) { f32x4 y = v[q][i] * ss[q] * g;
            if (MODE == 0) { y = y * s1 + s0; *(u32x2*)(hout + (size_t)(r + q) * D + c) = (u32x2){cvt_pk_bf16(y[0], y[1]), cvt_pk_bf16(y[2], y[3])}; }
            else *(f32x4*)(fout + (size_t)(r + q) * D + c) = y; } }
}
template <int MODE>
__device__ __forceinline__ void phase_norm(const Ctx& F, const float* xin, const float* gain, const float* sh, const float* sc, bf16_t* hout, float* fout) {
    for (int r = (blockIdx.x * 8 + F.wid) * 4; r < M; r += F.G * 32) norm_rows<MODE, 4>(F, r, xin, gain, sh, sc, hout, fout);
}

struct EpiGateT {
    static constexpr bool PERM = true; static constexpr bool KHOOK = false;
    unsigned char* g8;
    __device__ __forceinline__ void operator()(const f32x4 (&acc)[2][2][4][2], const pg8::Unit& u, int wr, int wc, int fr, int fq) const {
        unsigned char* tp = g8 + ((size_t)(u.pm * 32 + u.pn) * 512 + (size_t)((wr * 4 + wc) * 64 + fq * 16 + fr)) * 128;
#pragma unroll
        for (int ai = 0; ai < 2; ++ai)
#pragma unroll
            for (int m = 0; m < 4; ++m) { unsigned w[2][2];
#pragma unroll
                for (int bj = 0; bj < 2; ++bj)
#pragma unroll
                    for (int n = 0; n < 2; ++n) { const f32x4 v = acc[ai][bj][m][n]; unsigned q = 0;
#pragma unroll
                        for (int j = 0; j < 4; ++j) { const unsigned b = (unsigned)fminf(__builtin_amdgcn_rcpf(__builtin_fmaf(__expf(-v[j]), 0.00390625f, 0.00390625f)), 255.0f); q |= b << (8 * j); }
                        w[bj][n] = q; }
                *(u32x4*)(tp + (ai * 4 + m) * 16) = (u32x4){w[0][0], w[0][1], w[1][0], w[1][1]}; }
    }
};
struct EpiGlu {
    static constexpr bool PERM = true; static constexpr bool KHOOK = false;
    const bf16_t* yg; const float* bglu; bf16_t* ycat;
    __device__ __forceinline__ void operator()(const f32x4 (&acc)[2][2][4][2], const pg8::Unit& u, int wr, int wc, int fr, int fq) const {
        const int row0 = u.pm * 256 + wr * 64 + fr, col0 = u.pn * 256 + wc * 32 + 8 * fq;
        f32x4 bq[2][2];
#pragma unroll
        for (int bj = 0; bj < 2; ++bj) { bq[bj][0] = *(const f32x4*)(bglu + col0 + bj * 128); bq[bj][1] = *(const f32x4*)(bglu + col0 + bj * 128 + 4); }
#pragma unroll
        for (int ai = 0; ai < 2; ++ai) {
            u32x4 yq[4][2];
#pragma unroll
            for (int m = 0; m < 4; ++m)
#pragma unroll
                for (int bj = 0; bj < 2; ++bj) yq[m][bj] = *(const u32x4*)(yg + (size_t)(row0 + ai * 128 + m * 16) * BW + col0 + bj * 128);
#pragma unroll
            for (int m = 0; m < 4; ++m) { const size_t row = (size_t)(row0 + ai * 128 + m * 16);
#pragma unroll
                for (int bj = 0; bj < 2; ++bj) { const int col = col0 + bj * 128;
                    const u32x4 yv = yq[m][bj]; const f32x4 b0 = bq[bj][0], b1 = bq[bj][1];
                    const f32x4 v0 = acc[ai][bj][m][0] + b0, v1 = acc[ai][bj][m][1] + b1;
                    float o[8]; o[0] = bflo(yv[0]) * sigmoidf_(v0[0]); o[1] = bfhi(yv[0]) * sigmoidf_(v0[1]); o[2] = bflo(yv[1]) * sigmoidf_(v0[2]); o[3] = bfhi(yv[1]) * sigmoidf_(v0[3]);
                    o[4] = bflo(yv[2]) * sigmoidf_(v1[0]); o[5] = bfhi(yv[2]) * sigmoidf_(v1[1]); o[6] = bflo(yv[3]) * sigmoidf_(v1[2]); o[7] = bfhi(yv[3]) * sigmoidf_(v1[3]);
                    *(u32x4*)(ycat + row * D + col) = (u32x4){cvt_pk_bf16(o[0], o[1]), cvt_pk_bf16(o[2], o[3]), cvt_pk_bf16(o[4], o[5]), cvt_pk_bf16(o[6], o[7])}; } } }
    }
};
struct EpiBf16 {
    static constexpr bool PERM = true; static constexpr bool KHOOK = false;
    bf16_t* O; int ldc; int coff;
    __device__ __forceinline__ void operator()(const f32x4 (&acc)[2][2][4][2], const pg8::Unit& u, int wr, int wc, int fr, int fq) const {
        const int row0 = u.pm * 256 + wr * 64 + fr, col0 = coff + u.pn * 256 + wc * 32 + 8 * fq;
#pragma unroll
        for (int ai = 0; ai < 2; ++ai)
#pragma unroll
            for (int m = 0; m < 4; ++m) { bf16_t* rowp = O + (size_t)(row0 + ai * 128 + m * 16) * ldc + col0;
#pragma unroll
                for (int bj = 0; bj < 2; ++bj) { const f32x4 v0 = acc[ai][bj][m][0], v1 = acc[ai][bj][m][1];
                    *(u32x4*)(rowp + bj * 128) = (u32x4){cvt_pk_bf16(v0[0], v0[1]), cvt_pk_bf16(v0[2], v0[3]), cvt_pk_bf16(v1[0], v1[1]), cvt_pk_bf16(v1[2], v1[3])}; } }
    }
};
struct EpiMerge {
    static constexpr bool PERM = true; static constexpr bool KHOOK = true;
    const unsigned char* g8; bf16_t* mg;
    __device__ __forceinline__ const unsigned char* tile(const pg8::Unit& u, int n, int wr, int wc, int fr, int fq) const {
        return g8 + ((size_t)(u.pm * 32 + n * 8 + u.pn) * 512 + (size_t)((wr * 4 + wc) * 64 + fq * 16 + fr)) * 128; }
    __device__ __forceinline__ void khook(f32x4 (&acc)[2][2][4][2], const pg8::Unit& u, int j, int wr, int wc, int fr, int fq) const {
        const unsigned char* ta = tile(u, j - 1, wr, wc, fr, fq); const unsigned char* tb = tile(u, j, wr, wc, fr, fq);
        u32x4 ga[2], gb[2];
        ga[0] = *(const u32x4*)ta; gb[0] = *(const u32x4*)tb; ga[1] = *(const u32x4*)(ta + 16); gb[1] = *(const u32x4*)(tb + 16);
#pragma unroll
        for (int q = 0; q < 8; ++q) { const int ai = q >> 2, m = q & 3; const u32x4 a4 = ga[q & 1], b4 = gb[q & 1];
            if (q + 2 < 8) { ga[q & 1] = *(const u32x4*)(ta + (q + 2) * 16); gb[q & 1] = *(const u32x4*)(tb + (q + 2) * 16); }
#pragma unroll
            for (int bj = 0; bj < 2; ++bj)
#pragma unroll
                for (int n = 0; n < 2; ++n) { const unsigned wa = a4[bj * 2 + n], wb = b4[bj * 2 + n];
#pragma unroll
                    for (int jj = 0; jj < 4; ++jj) acc[ai][bj][m][n][jj] *= ((float)((wa >> (8 * jj)) & 255u) + 0.5f) * __builtin_amdgcn_rcpf((float)((wb >> (8 * jj)) & 255u) + 0.5f); } }
    }
    __device__ __forceinline__ void operator()(const f32x4 (&acc)[2][2][4][2], const pg8::Unit& u, int wr, int wc, int fr, int fq) const {
        const int row0 = u.pm * 256 + wr * 64 + fr, col0 = u.pn * 256 + wc * 32 + 8 * fq;
        const unsigned char* tp = tile(u, 3, wr, wc, fr, fq);
        u32x4 gq[8];
#pragma unroll
        for (int q = 0; q < 8; ++q) gq[q] = *(const u32x4*)(tp + q * 16);
#pragma unroll
        for (int q = 0; q < 8; ++q) { const int ai = q >> 2, m = q & 3; const size_t row = (size_t)(row0 + ai * 128 + m * 16); const u32x4 g4 = gq[q];
#pragma unroll
            for (int bj = 0; bj < 2; ++bj) { const f32x4 v0 = acc[ai][bj][m][0], v1 = acc[ai][bj][m][1]; float o[8];
#pragma unroll
                for (int jj = 0; jj < 4; ++jj) { o[jj] = v0[jj] * __builtin_fmaf((float)((g4[bj * 2] >> (8 * jj)) & 255u), 1.0f / 256.0f, 0.5f / 256.0f); o[4 + jj] = v1[jj] * __builtin_fmaf((float)((g4[bj * 2 + 1] >> (8 * jj)) & 255u), 1.0f / 256.0f, 0.5f / 256.0f); }
                *(u32x4*)(mg + row * D + col0 + bj * 128) = (u32x4){cvt_pk_bf16(o[0], o[1]), cvt_pk_bf16(o[2], o[3]), cvt_pk_bf16(o[4], o[5]), cvt_pk_bf16(o[6], o[7])}; } }
    }
};
struct EpiResid {
    static constexpr bool PERM = false; static constexpr bool KHOOK = false;
    const float* xin; const float* gvec; float* xout;
    __device__ __forceinline__ void operator()(const f32x4 (&acc)[2][2][4][2], const pg8::Unit& u, int wr, int wc, int fr, int fq) const {
        const int row0 = u.pm * 256 + wr * 64 + fr, col0 = u.pn * 256 + wc * 32 + 4 * fq, b = u.pm / 8;
        f32x4 gv[2][2];
#pragma unroll
        for (int bj = 0; bj < 2; ++bj)
#pragma unroll
            for (int n = 0; n < 2; ++n) gv[bj][n] = *(const f32x4*)(gvec + (size_t)b * ADA + col0 + bj * 128 + n * 16);
        f32x4 xv[2][4];
#pragma unroll
        for (int q = 0; q < 2; ++q)
#pragma unroll
            for (int c = 0; c < 4; ++c) xv[q][c] = *(const f32x4*)(xin + (size_t)(row0 + (q >> 2) * 128 + (q & 3) * 16) * D + col0 + (c >> 1) * 128 + (c & 1) * 16);
#pragma unroll
        for (int q = 0; q < 8; ++q) { const int ai = q >> 2, m = q & 3; const size_t off = (size_t)(row0 + ai * 128 + m * 16) * D + col0;
            f32x4 cur[4];
#pragma unroll
            for (int c = 0; c < 4; ++c) cur[c] = xv[q & 1][c];
            if (q + 2 < 8) {
#pragma unroll
                for (int c = 0; c < 4; ++c) xv[q & 1][c] = *(const f32x4*)(xin + (size_t)(row0 + ((q + 2) >> 2) * 128 + ((q + 2) & 3) * 16) * D + col0 + (c >> 1) * 128 + (c & 1) * 16); }
#pragma unroll
            for (int c = 0; c < 4; ++c) *(f32x4*)(xout + off + (c >> 1) * 128 + (c & 1) * 16) = cur[c] + gv[c >> 1][c & 1] * acc[ai][c >> 1][m][c & 1];
        }
    }
};
struct EpiResidN {
    static constexpr bool PERM = true; static constexpr bool KHOOK = false;
    const float* xin; const float* gvec; float* xout; const float* gain; const float* sc; bf16_t* hraw; unsigned long long* rss;
    __device__ __forceinline__ void operator()(const f32x4 (&acc)[2][2][4][2], const pg8::Unit& u, int wr, int wc, int fr, int fq) const {
        const int row0 = u.pm * 256 + wr * 64 + fr, col0 = u.pn * 256 + wc * 32 + 8 * fq, b = u.pm / 8;
        float ssq[8];
#pragma unroll
        for (int bj = 0; bj < 2; ++bj) { const int cb = col0 + bj * 128;
            const f32x4 gv0 = *(const f32x4*)(gvec + (size_t)b * ADA + cb), gv1 = *(const f32x4*)(gvec + (size_t)b * ADA + cb + 4);
            const f32x4 wm0 = *(const f32x4*)(gain + cb) * (*(const f32x4*)(sc + (size_t)b * ADA + cb) + 1.0f), wm1 = *(const f32x4*)(gain + cb + 4) * (*(const f32x4*)(sc + (size_t)b * ADA + cb + 4) + 1.0f);
            f32x4 xv[4][2];
#pragma unroll
            for (int q = 0; q < 4; ++q) { const float* xp = xin + (size_t)(row0 + (q >> 2) * 128 + (q & 3) * 16) * D + cb; xv[q][0] = __builtin_nontemporal_load((const f32x4*)xp); xv[q][1] = __builtin_nontemporal_load((const f32x4*)(xp + 4)); }
#pragma unroll
            for (int q = 0; q < 8; ++q) { const int ai = q >> 2, m = q & 3; const size_t off = (size_t)(row0 + ai * 128 + m * 16) * D + cb;
                f32x4 o0 = xv[q & 3][0], o1 = xv[q & 3][1];
                if (q + 4 < 8) { const float* xp = xin + (size_t)(row0 + ((q + 4) >> 2) * 128 + ((q + 4) & 3) * 16) * D + cb; xv[q & 3][0] = __builtin_nontemporal_load((const f32x4*)xp); xv[q & 3][1] = __builtin_nontemporal_load((const f32x4*)(xp + 4)); }
                o0 = o0 + gv0 * acc[ai][bj][m][0]; o1 = o1 + gv1 * acc[ai][bj][m][1];
                *(f32x4*)(xout + off) = o0; *(f32x4*)(xout + off + 4) = o1;
                const float ss = (o0[0] * o0[0] + o0[1] * o0[1] + o0[2] * o0[2] + o0[3] * o0[3]) + (o1[0] * o1[0] + o1[1] * o1[1] + o1[2] * o1[2] + o1[3] * o1[3]);
                ssq[q] = bj == 0 ? ss : ssq[q] + ss;
                const f32x4 y0 = o0 * wm0, y1 = o1 * wm1;
                *(u32x4*)(hraw + off) = (u32x4){cvt_pk_bf16(y0[0], y0[1]), cvt_pk_bf16(y0[2], y0[3]), cvt_pk_bf16(y1[0], y1[1]), cvt_pk_bf16(y1[2], y1[3])}; } }
#pragma unroll
        for (int q = 0; q < 8; ++q) { float ss = ssq[q]; ss += __shfl_xor(ss, 16); ss += __shfl_xor(ss, 32);
            if (fq == 0) (void)__hip_atomic_fetch_add(rss + row0 + (q >> 2) * 128 + (q & 3) * 16, (unsigned long long)(ss * RSS_SCALE), __ATOMIC_RELAXED, __HIP_MEMORY_SCOPE_AGENT); }
    }
};
struct EpiScore {
    static constexpr bool PERM = true; static constexpr bool KHOOK = false;
    bf16_t* C; const unsigned long long* rss; const float* c0;
    __device__ __forceinline__ void operator()(const f32x4 (&acc)[2][2][4][2], const pg8::Unit& u, int wr, int wc, int fr, int fq) const {
        const int row0 = u.pm * 256 + wr * 64 + fr, col0 = u.pn * 256 + wc * 32 + 8 * fq, b = u.pm / 8;
        f32x4 cv[2][2];
#pragma unroll
        for (int bj = 0; bj < 2; ++bj)
#pragma unroll
            for (int n = 0; n < 2; ++n) cv[bj][n] = *(const f32x4*)(c0 + (size_t)b * D + col0 + bj * 128 + n * 4);
        unsigned long long rq[8];
#pragma unroll
        for (int q = 0; q < 8; ++q) rq[q] = rss[row0 + (q >> 2) * 128 + (q & 3) * 16];
#pragma unroll
        for (int ai = 0; ai < 2; ++ai)
#pragma unroll
            for (int m = 0; m < 4; ++m) { const int row = row0 + ai * 128 + m * 16; bf16_t* rowp = C + (size_t)row * D + col0; const float rs = rsqrtf((float)rq[ai * 4 + m] * (RSS_INV / D) + EPS);
#pragma unroll
                for (int bj = 0; bj < 2; ++bj) { const f32x4 v0 = acc[ai][bj][m][0] * rs + cv[bj][0], v1 = acc[ai][bj][m][1] * rs + cv[bj][1];
                    *(u32x4*)(rowp + bj * 128) = (u32x4){cvt_pk_bf16(v0[0], v0[1]), cvt_pk_bf16(v0[2], v0[3]), cvt_pk_bf16(v1[0], v1[1]), cvt_pk_bf16(v1[2], v1[3])}; } }
    }
};
__device__ __forceinline__ void aux_shift_tables(const Ctx& F, const Params& p, int l) {
    const float* sh = (const float*)(p.ws + WS_MOD) + (size_t)l * BATCH * ADA + 3 * D;
    unsigned long long* rss = (unsigned long long*)(p.ws + WS_RSS); float* c0 = (float*)(p.ws + WS_C0); float* sd = (float*)(p.ws + WS_SD);
    LAS unsigned char* shb = F.lds;
    LAS f32x4* red = (LAS f32x4*)(F.lds + 16 * 4112);
    __syncthreads();
    for (int i = blockIdx.x * 512 + F.tid; i < M; i += F.G * 512) rss[i] = 0ull;
    for (int i = F.tid; i < 16 * 512; i += 512) { const int b = i >> 9, c4 = (i & 511) * 4; const f32x4 v = *(const f32x4*)(sh + (size_t)b * ADA + c4);
        *(LAS u32x2*)(shb + b * 4112 + c4 * 2) = (u32x2){cvt_pk_bf16(v[0], v[1]), cvt_pk_bf16(v[2], v[3])}; }
    __syncthreads();
    const int fr = F.lane & 15, fq = F.lane >> 4;
    const LAS unsigned char* ap = shb + fr * 4112 + fq * 16;
    for (int eb = blockIdx.x; eb < NEXP / 64; eb += F.G) {
        const int nb = F.wid & 3, kh = F.wid >> 2, e = eb * 64 + nb * 16 + fr;
        const unsigned char* up = p.ws + WS_PU8 + (size_t)l * 16 * NEXP * 128 + (size_t)e * 128 + fq * 8;
        f32x4 acc = (f32x4){0.f, 0.f, 0.f, 0.f};
#pragma unroll 2
        for (int s = kh * 8; s < kh * 8 + 8; ++s) {
            u32x2 w[4];
#pragma unroll
            for (int kk = 0; kk < 4; ++kk) w[kk] = *(const u32x2*)(up + (size_t)s * NEXP * 128 + kk * 32);
#pragma unroll
            for (int kk = 0; kk < 4; ++kk) {
                const f32x2 a0 = __builtin_amdgcn_cvt_pk_f32_fp8((int)w[kk][0], false), a1 = __builtin_amdgcn_cvt_pk_f32_fp8((int)w[kk][0], true);
                const f32x2 a2 = __builtin_amdgcn_cvt_pk_f32_fp8((int)w[kk][1], false), a3 = __builtin_amdgcn_cvt_pk_f32_fp8((int)w[kk][1], true);
                const u32x4 bw = (u32x4){cvt_pk_bf16(a0[0], a0[1]), cvt_pk_bf16(a1[0], a1[1]), cvt_pk_bf16(a2[0], a2[1]), cvt_pk_bf16(a3[0], a3[1])};
                const bf16x8 af = *(const LAS bf16x8*)(ap + (s * 128 + kk * 32) * 2);
                acc = __builtin_amdgcn_mfma_f32_16x16x32_bf16(af, __builtin_bit_cast(bf16x8, bw), acc, 0, 0, 0); } }
        if (kh == 1) red[(F.wid - 4) * 64 + F.lane] = acc;
        __syncthreads();
        if (kh == 0) { const f32x4 o = acc + red[F.wid * 64 + F.lane];
#pragma unroll
            for (int r = 0; r < 4; ++r) sd[(size_t)(4 * fq + r) * NEXP + e] = o[r]; }
        __syncthreads();
    }
    for (int nbk = blockIdx.x; nbk < D / 16; nbk += F.G) {
        const bf16_t* wp = (const bf16_t*)(p.ws + WS_WQT) + (size_t)l * D * D + (size_t)(nbk * 16 + fr) * D + F.wid * 256 + fq * 8;
        f32x4 acc = (f32x4){0.f, 0.f, 0.f, 0.f};
#pragma unroll
        for (int kk = 0; kk < 8; ++kk) { const bf16x8 bf = *(const bf16x8*)(wp + kk * 32); const bf16x8 af = *(const LAS bf16x8*)(ap + (F.wid * 256 + kk * 32) * 2);
            acc = __builtin_amdgcn_mfma_f32_16x16x32_bf16(af, bf, acc, 0, 0, 0); }
        red[F.wid * 64 + F.lane] = acc;
        __syncthreads();
        if (F.wid == 0) { f32x4 o = red[F.lane];
#pragma unroll
            for (int w = 1; w < 8; ++w) o = o + red[w * 64 + F.lane];
#pragma unroll
            for (int r = 0; r < 4; ++r) c0[(size_t)(4 * fq + r) * D + nbk * 16 + fr] = o[r]; }
        __syncthreads();
    }
}
struct EpiF32 {
    static constexpr bool PERM = false; static constexpr bool KHOOK = false;
    float* C; int ldc;
    __device__ __forceinline__ void operator()(const f32x4 (&acc)[2][2][4][2], const pg8::Unit& u, int wr, int wc, int fr, int fq) const {
        const int row0 = u.pm * 256 + wr * 64 + fr, col0 = u.pn * 256 + wc * 32 + 4 * fq;
#pragma unroll
        for (int ai = 0; ai < 2; ++ai)
#pragma unroll
            for (int m = 0; m < 4; ++m) { float* rowp = C + (size_t)(row0 + ai * 128 + m * 16) * ldc + col0;
#pragma unroll
                for (int bj = 0; bj < 2; ++bj)
#pragma unroll
                    for (int n = 0; n < 2; ++n) *(f32x4*)(rowp + bj * 128 + n * 16) = acc[ai][bj][m][n]; }
    }
};

__device__ __forceinline__ void mix_hgrn2(const Ctx& F, const Params& p, int l, int it) {
    const int b = it >> 2, hd = it & 3;
    const bf16_t* proj = (const bf16_t*)(p.ws + WS_PROJ);
    bf16_t* ycat = (bf16_t*)(p.ws + WS_YCAT);
    const float* lbp = (const float*)(p.ws + WS_LB) + l * BW + hd * 128;
    LAS bf16_t* QH = (LAS bf16_t*)F.lds;
    LAS bf16_t* Q1 = QH + 32 * 136;
    LAS bf16_t* K0 = Q1 + 16 * 136;
    LAS bf16_t* KT = K0 + 16 * 136;
    LAS bf16_t* VT = KT + 128 * 40;
    LAS bf16_t* AM = VT + 128 * 40;
    LAS bf16_t* ST = AM + 32 * 40;
    LAS bf16_t* qsB = ST + 128 * 136;
    LAS bf16_t* kkB = qsB + 32 * 128;
    LAS float* bF = (LAS float*)(kkB + 32 * 128);
    LAS float* OS = bF + 32 * 128;
    LAS float* tot = OS + 32 * 132;
    const int d = F.tid & 127, tq = F.tid >> 7, ln = F.lane, l15 = ln & 15, lq = ln >> 4, w = F.wid;
    const float lb = lbp[d];
    __syncthreads();
    for (int i = F.tid; i < 128 * 136 / 8; i += 512) ((LAS u32x4*)ST)[i] = (u32x4){0u, 0u, 0u, 0u};
    f32x4 accS[8];
#pragma unroll
    for (int nt = 0; nt < 8; ++nt) accS[nt] = (f32x4){0.f, 0.f, 0.f, 0.f};
    unsigned rq[8], rf[8], rv[8];
    { const bf16_t* pr = proj + (size_t)(b * SEQ + tq * 8) * INC + hd * 128 + d;
#pragma unroll
      for (int i = 0; i < 8; ++i) { rq[i] = pr[(size_t)i * INC + 512]; rf[i] = pr[(size_t)i * INC + 1024]; rv[i] = pr[(size_t)i * INC + 1536]; } }
    float gnv[8];
    { const float* gn = p.hg_gain + l * BW + hd * 128 + (F.tid & 15) * 8;
#pragma unroll
      for (int j = 0; j < 8; ++j) gnv[j] = gn[j]; }
    for (int t0 = 0; t0 < SEQ; t0 += 32) {
        const u32x4 gv = *(const u32x4*)(proj + (size_t)(b * SEQ + t0 + (F.tid >> 4)) * INC + 2048 + hd * 128 + (F.tid & 15) * 8);
        float qs[8], kk[8], cs[8], fd[8]; unsigned vraw[8];
        { float run = 0.f;
#pragma unroll
          for (int i = 0; i < 8; ++i) { const float qv = bf2f(rq[i]), fv = bf2f(rf[i]); vraw[i] = rv[i];
              const float fg = lb + (1.0f - lb) * sigmoidf_(fv); fd[i] = fmaxf(fg, 1e-6f); run += __logf(fd[i]); cs[i] = run; kk[i] = 1.0f - fg; qs[i] = siluf_(qv); }
          tot[tq * 128 + d] = run;
          const int tn0 = (t0 + 32 < SEQ) ? t0 + 32 : t0; const bf16_t* pr = proj + (size_t)(b * SEQ + tn0 + tq * 8) * INC + hd * 128 + d;
#pragma unroll
          for (int i = 0; i < 8; ++i) { rq[i] = pr[(size_t)i * INC + 512]; rf[i] = pr[(size_t)i * INC + 1024]; rv[i] = pr[(size_t)i * INC + 1536]; } }
        __syncthreads();
        {   const float t0v = tot[d], t1v = tot[128 + d], t2v = tot[256 + d], t3v = tot[384 + d];
            const float ref1 = t0v + t1v, blast = ref1 + t2v + t3v, off = (tq > 0 ? t0v : 0.f) + (tq > 1 ? t1v : 0.f) + (tq > 2 ? t2v : 0.f);
            unsigned ktw[4];
#pragma unroll
            for (int i = 0; i < 8; ++i) { const int t = tq * 8 + i; const float bt = off + cs[i];
                bF[t * 128 + d] = fd[i]; qsB[t * 128 + d] = f2bf(qs[i]); kkB[t * 128 + d] = f2bf(kk[i]);
                QH[t * 136 + d] = f2bf(qs[i] * __expf(bt));
                const float kt = kk[i] * __expf(blast - bt);
                if (i & 1) ktw[i >> 1] = cvt_pk_bf16(__uint_as_float(ktw[i >> 1]), kt); else ktw[i >> 1] = __float_as_uint(kt);
                if (tq >= 2) Q1[(t - 16) * 136 + d] = f2bf(qs[i] * __expf(bt - ref1)); else K0[t * 136 + d] = f2bf(kk[i] * __expf(ref1 - bt)); }
            *(LAS u32x4*)(KT + d * 40 + tq * 8) = (u32x4){ktw[0], ktw[1], ktw[2], ktw[3]};
            *(LAS u32x4*)(VT + d * 40 + tq * 8) = (u32x4){vraw[0] | (vraw[1] << 16), vraw[2] | (vraw[3] << 16), vraw[4] | (vraw[5] << 16), vraw[6] | (vraw[7] << 16)}; }
        __syncthreads();
#pragma unroll 1
        for (int rr = 0; rr < 4; ++rr) { const int sb = rr >> 1, tl = (rr & 1) ? 15 - w : w, t = sb * 16 + tl;
            const float q0 = bf2f(qsB[t * 128 + ln]), q1 = bf2f(qsB[t * 128 + 64 + ln]);
            float v[16]; float e0 = 1.f, e1 = 1.f;
#pragma unroll
            for (int sl = 15; sl >= 0; --sl) { const int s2 = sb * 16 + sl;
                if (sl <= tl) { v[sl] = q0 * bf2f(kkB[s2 * 128 + ln]) * e0 + q1 * bf2f(kkB[s2 * 128 + 64 + ln]) * e1; e0 *= bF[s2 * 128 + ln]; e1 *= bF[s2 * 128 + 64 + ln]; }
                else v[sl] = 0.f; }
            const bool c5 = ln & 32, c4 = ln & 16, c3 = ln & 8, c2 = ln & 4;
            float v8[8], v4[4], v2[2], v1;
#pragma unroll
            for (int i = 0; i < 8; ++i) { const float snd = c5 ? v[i] : v[i + 8]; const float rcv = __shfl_xor(snd, 32); v8[i] = (c5 ? v[i + 8] : v[i]) + rcv; }
#pragma unroll
            for (int i = 0; i < 4; ++i) { const float snd = c4 ? v8[i] : v8[i + 4]; const float rcv = __shfl_xor(snd, 16); v4[i] = (c4 ? v8[i + 4] : v8[i]) + rcv; }
#pragma unroll
            for (int i = 0; i < 2; ++i) { const float snd = c3 ? v4[i] : v4[i + 2]; const float rcv = __shfl_xor(snd, 8); v2[i] = (c3 ? v4[i + 2] : v4[i]) + rcv; }
            { const float snd = c2 ? v2[0] : v2[1]; const float rcv = __shfl_xor(snd, 4); v1 = (c2 ? v2[1] : v2[0]) + rcv; }
            v1 += __shfl_xor(v1, 2); v1 += __shfl_xor(v1, 1);
            const int sl = ln >> 2;
            if ((ln & 3) == 0) AM[t * 40 + sb * 16 + sl] = f2bf(sl <= tl ? v1 : 0.f);
            else if ((ln & 3) == 1 && sb == 0) AM[t * 40 + 16 + sl] = (bf16_t)0; }
        if (w == 0) { f32x4 o10 = (f32x4){0.f, 0.f, 0.f, 0.f};
#pragma unroll
            for (int ks = 0; ks < 4; ++ks) { const bf16x8 a = *(const LAS bf16x8*)(Q1 + l15 * 136 + 32 * ks + 8 * lq), bb = *(const LAS bf16x8*)(K0 + l15 * 136 + 32 * ks + 8 * lq); o10 = __builtin_amdgcn_mfma_f32_16x16x32_bf16(a, bb, o10, 0, 0, 0); }
#pragma unroll
            for (int r = 0; r < 4; ++r) AM[(16 + 4 * lq + r) * 40 + l15] = f2bf(o10[r]); }
        __syncthreads();
        const int mt = w & 1, np = w >> 1;
        f32x4 ao[2];
#pragma unroll
        for (int nt = 0; nt < 2; ++nt) { ao[nt] = (f32x4){0.f, 0.f, 0.f, 0.f}; const int en = 16 * (2 * np + nt) + l15;
#pragma unroll
            for (int ks = 0; ks < 4; ++ks) { const bf16x8 a = *(const LAS bf16x8*)(QH + (16 * mt + l15) * 136 + 32 * ks + 8 * lq), bb = *(const LAS bf16x8*)(ST + en * 136 + 32 * ks + 8 * lq); ao[nt] = __builtin_amdgcn_mfma_f32_16x16x32_bf16(a, bb, ao[nt], 0, 0, 0); }
            const bf16x8 a2 = *(const LAS bf16x8*)(AM + (16 * mt + l15) * 40 + 8 * lq), b2 = *(const LAS bf16x8*)(VT + en * 40 + 8 * lq); ao[nt] = __builtin_amdgcn_mfma_f32_16x16x32_bf16(a2, b2, ao[nt], 0, 0, 0); }
        {   float dec[4];
#pragma unroll
            for (int r = 0; r < 4; ++r) { const int dd = 16 * w + 4 * lq + r; dec[r] = __expf(tot[dd] + tot[128 + dd] + tot[256 + dd] + tot[384 + dd]); }
            const bf16x8 a3 = *(const LAS bf16x8*)(KT + (16 * w + l15) * 40 + 8 * lq);
#pragma unroll
            for (int nt = 0; nt < 8; ++nt) { f32x4 c = accS[nt];
#pragma unroll
                for (int r = 0; r < 4; ++r) c[r] *= dec[r];
                const bf16x8 b3 = *(const LAS bf16x8*)(VT + (16 * nt + l15) * 40 + 8 * lq); accS[nt] = __builtin_amdgcn_mfma_f32_16x16x32_bf16(a3, b3, c, 0, 0, 0); } }
        __syncthreads();
#pragma unroll
        for (int nt = 0; nt < 8; ++nt)
#pragma unroll
            for (int r = 0; r < 4; ++r) ST[(16 * nt + l15) * 136 + 16 * w + 4 * lq + r] = f2bf(accS[nt][r]);
#pragma unroll
        for (int nt = 0; nt < 2; ++nt)
#pragma unroll
            for (int r = 0; r < 4; ++r) OS[(16 * mt + 4 * lq + r) * 132 + 16 * (2 * np + nt) + l15] = ao[nt][r];
        __syncthreads();
        {   const int t = F.tid >> 4, e0 = (F.tid & 15) * 8; float o[8]; float ss = 0.f;
#pragma unroll
            for (int j = 0; j < 8; ++j) { o[j] = OS[t * 132 + e0 + j]; ss += o[j] * o[j]; }
            ss += __shfl_xor(ss, 1); ss += __shfl_xor(ss, 2); ss += __shfl_xor(ss, 4); ss += __shfl_xor(ss, 8);
            const float rs = rsqrtf(ss * (1.0f / 128.0f) + EPS);
            const size_t row = (size_t)(b * SEQ + t0 + t);
            float r[8];
#pragma unroll
            for (int j = 0; j < 8; ++j) { const float gg = (j & 1) ? bfhi(gv[j >> 1]) : bflo(gv[j >> 1]); r[j] = o[j] * rs * gnv[j] * siluf_(gg); }
            *(u32x4*)(ycat + row * D + 512 + hd * 128 + e0) = (u32x4){cvt_pk_bf16(r[0], r[1]), cvt_pk_bf16(r[2], r[3]), cvt_pk_bf16(r[4], r[5]), cvt_pk_bf16(r[6], r[7])};
        }
    }
}
__device__ __forceinline__ void mix_sb(const Ctx& F, const Params& p, int it) {
    const int qb = 15 - (it >> 6), bh = it & 63, b = bh >> 2, hd = bh & 3;
    const bf16_t* proj = (const bf16_t*)(p.ws + WS_PROJ);
    bf16_t* ycat = (bf16_t*)(p.ws + WS_YCAT);
    constexpr int KP = 136, VP = 72, SP = 72;
    LAS bf16_t* Kt = (LAS bf16_t*)F.lds;
    LAS bf16_t* Vt = Kt + 64 * KP;
    LAS bf16_t* Ws = Vt + 128 * VP + F.wid * (3 * 16 * SP);
    const int ln = F.lane, l15 = ln & 15, lq = ln >> 4;
    const int trow0 = qb * 128 + F.wid * 16;
    bf16x8 qa[4];
    { const bf16_t* qp = proj + (size_t)(b * SEQ + trow0 + l15) * INC + 2560 + hd * 128 + 8 * lq;
#pragma unroll
      for (int ks = 0; ks < 4; ++ks) qa[ks] = *(const bf16x8*)(qp + 32 * ks); }
    bf16x8 uA, uB, uOne;
#pragma unroll
    for (int j = 0; j < 8; ++j) { const int kk = 8 * lq + j; uA[j] = (kk > l15) ? (short)0x3F80 : (short)0; uB[j] = (kk > 16 + l15) ? (short)0x3F80 : (short)0; uOne[j] = (short)0x3F80; }
    f32x4 O[8];
#pragma unroll
    for (int nt = 0; nt < 8; ++nt) O[nt] = (f32x4){0.f, 0.f, 0.f, 0.f};
    float run[4] = {0.f, 0.f, 0.f, 0.f};
    for (int kt = qb * 2 + 1; kt >= 0; --kt) {
        __syncthreads();
#pragma unroll
        for (int c2 = 0; c2 < 2; ++c2) { const int c = F.tid + 512 * c2, row = c >> 4, c8 = (c & 15) * 8; const size_t rb = (size_t)(b * SEQ + kt * 64 + row) * INC + hd * 128 + c8;
            const u32x4 kw = *(const u32x4*)(proj + rb + 3072), vw = *(const u32x4*)(proj + rb + 3584);
            *(LAS u32x4*)(Kt + row * KP + c8) = kw;
#pragma unroll
            for (int j = 0; j < 4; ++j) { Vt[(c8 + 2 * j) * VP + row] = (bf16_t)(vw[j] & 0xffffu); Vt[(c8 + 2 * j + 1) * VP + row] = (bf16_t)(vw[j] >> 16); } }
        __syncthreads();
        f32x4 z[4];
#pragma unroll
        for (int nt = 0; nt < 4; ++nt) { z[nt] = (f32x4){0.f, 0.f, 0.f, 0.f};
#pragma unroll
            for (int ks = 0; ks < 4; ++ks) { const bf16x8 kf = *(const LAS bf16x8*)(Kt + (16 * nt + l15) * KP + 32 * ks + 8 * lq); z[nt] = __builtin_amdgcn_mfma_f32_16x16x32_bf16(qa[ks], kf, z[nt], 0, 0, 0); } }
        float lbv[4][4]; bool vld[4][4];
#pragma unroll
        for (int nt = 0; nt < 4; ++nt)
#pragma unroll
            for (int r = 0; r < 4; ++r) { const float zz = z[nt][r] * 0.08838834764831845f; const float sp = fmaxf(zz, 0.f) + __logf(1.0f + __expf(-fabsf(zz)));
                const bool valid = (kt * 64 + 16 * nt + l15) < (trow0 + 4 * lq + r); vld[nt][r] = valid; lbv[nt][r] = zz - sp;
                const float lnv = valid ? -sp : 0.f; const unsigned hi = cvt_pk_bf16(lnv, 0.f) & 0xffffu; const float lo = lnv - __uint_as_float(hi << 16);
                Ws[(4 * lq + r) * SP + 16 * nt + l15] = (bf16_t)hi; Ws[(16 + 4 * lq + r) * SP + 16 * nt + l15] = f2bf(lo); }
        __syncthreads();
        bf16x8 ah[2], al[2];
#pragma unroll
        for (int ks = 0; ks < 2; ++ks) { ah[ks] = *(const LAS bf16x8*)(Ws + l15 * SP + 32 * ks + 8 * lq); al[ks] = *(const LAS bf16x8*)(Ws + (16 + l15) * SP + 32 * ks + 8 * lq); }
        f32x4 sfx[4], tot = (f32x4){0.f, 0.f, 0.f, 0.f};
#pragma unroll
        for (int nt = 0; nt < 4; ++nt) sfx[nt] = (f32x4){0.f, 0.f, 0.f, 0.f};
        sfx[0] = __builtin_amdgcn_mfma_f32_16x16x32_bf16(ah[0], uA, sfx[0], 0, 0, 0);   sfx[0] = __builtin_amdgcn_mfma_f32_16x16x32_bf16(al[0], uA, sfx[0], 0, 0, 0);
        sfx[1] = __builtin_amdgcn_mfma_f32_16x16x32_bf16(ah[0], uB, sfx[1], 0, 0, 0);   sfx[1] = __builtin_amdgcn_mfma_f32_16x16x32_bf16(al[0], uB, sfx[1], 0, 0, 0);
        sfx[0] = __builtin_amdgcn_mfma_f32_16x16x32_bf16(ah[1], uOne, sfx[0], 0, 0, 0); sfx[0] = __builtin_amdgcn_mfma_f32_16x16x32_bf16(al[1], uOne, sfx[0], 0, 0, 0);
        sfx[1] = __builtin_amdgcn_mfma_f32_16x16x32_bf16(ah[1], uOne, sfx[1], 0, 0, 0); sfx[1] = __builtin_amdgcn_mfma_f32_16x16x32_bf16(al[1], uOne, sfx[1], 0, 0, 0);
        sfx[2] = __builtin_amdgcn_mfma_f32_16x16x32_bf16(ah[1], uA, sfx[2], 0, 0, 0);   sfx[2] = __builtin_amdgcn_mfma_f32_16x16x32_bf16(al[1], uA, sfx[2], 0, 0, 0);
        sfx[3] = __builtin_amdgcn_mfma_f32_16x16x32_bf16(ah[1], uB, sfx[3], 0, 0, 0);   sfx[3] = __builtin_amdgcn_mfma_f32_16x16x32_bf16(al[1], uB, sfx[3], 0, 0, 0);
#pragma unroll
        for (int ks = 0; ks < 2; ++ks) { tot = __builtin_amdgcn_mfma_f32_16x16x32_bf16(ah[ks], uOne, tot, 0, 0, 0); tot = __builtin_amdgcn_mfma_f32_16x16x32_bf16(al[ks], uOne, tot, 0, 0, 0); }
#pragma unroll
        for (int nt = 0; nt < 4; ++nt)
#pragma unroll
            for (int r = 0; r < 4; ++r) { const float w = vld[nt][r] ? __expf(lbv[nt][r] + sfx[nt][r] + run[r]) : 0.f; Ws[(32 + 4 * lq + r) * SP + 16 * nt + l15] = f2bf(w); }
#pragma unroll
        for (int r = 0; r < 4; ++r) run[r] += tot[r];
        __syncthreads();
        bf16x8 wf[2];
#pragma unroll
        for (int ks = 0; ks < 2; ++ks) wf[ks] = *(const LAS bf16x8*)(Ws + (32 + l15) * SP + 32 * ks + 8 * lq);
#pragma unroll
        for (int nt = 0; nt < 8; ++nt)
#pragma unroll
            for (int ks = 0; ks < 2; ++ks) { const bf16x8 vf = *(const LAS bf16x8*)(Vt + (16 * nt + l15) * VP + 32 * ks + 8 * lq); O[nt] = __builtin_amdgcn_mfma_f32_16x16x32_bf16(wf[ks], vf, O[nt], 0, 0, 0); }
        {   const bool live = !(run[0] < -110.0f && run[1] < -110.0f && run[2] < -110.0f && run[3] < -110.0f);
            __syncthreads();
            if (F.tid == 0) F.misc[9] = 0u;
            __syncthreads();
            if (live) F.misc[9] = 1u;
            __syncthreads();
            if (F.misc[9] == 0u) break;
        }
    }
#pragma unroll
    for (int nt = 0; nt < 8; ++nt)
#pragma unroll
        for (int r = 0; r < 4; ++r) ycat[(size_t)(b * SEQ + trow0 + 4 * lq + r) * D + 1024 + hd * 128 + 16 * nt + l15] = f2bf(O[nt][r]);
}
__device__ __forceinline__ void mix_s5(const Ctx& F, const Params& p, int l, int it) {
    const int b = it >> 5, g = it & 31, w = F.wid, ln = F.lane, l15 = ln & 15, lq = ln >> 4;
    const bf16_t* proj = (const bf16_t*)(p.ws + WS_PROJ);
    bf16_t* yg = (bf16_t*)(p.ws + WS_YG);
    constexpr int BP = 132, XP = 136;
    LAS float* bu = (LAS float*)(F.lds + w * (16 * BP * 4 + 16 * XP * 2));
    LAS bf16_t* xs = (LAS bf16_t*)((LAS unsigned char*)bu + 16 * BP * 4);
    LAS float* ends = (LAS float*)(F.lds + MISC_OFF + 256);
    const float* sp = (const float*)(p.ws + WS_S5P) + (size_t)((l * 32 + g) * 64) * 36;
    const float are = sp[ln * 36], aim = sp[ln * 36 + 1];
    bf16x8 bfr[8];
#pragma unroll
    for (int nt = 0; nt < 8; ++nt) { const int col = 16 * nt + l15, pp = col & 63; const float* q = sp + pp * 36 + ((col >> 6) ? 20 : 4) + 8 * lq;
#pragma unroll
        for (int j = 0; j < 8; ++j) bfr[nt][j] = (lq < 2) ? (short)f2bf(q[j]) : (short)0; }
    bf16x8 cfr[4];
#pragma unroll
    for (int ks = 0; ks < 4; ++ks) { const int k0 = 32 * ks + 8 * lq; const float* cp = ((ks < 2) ? p.c_re : p.c_im) + (((size_t)l * 32 + g) * 16 + l15) * 64 + (k0 & 63);
#pragma unroll
        for (int j = 0; j < 8; ++j) cfr[ks][j] = (short)f2bf((ks < 2) ? cp[j] : -cp[j]); }
    const float dsk = p.s5_d[l * BW + g * 16 + l15];
    const bf16_t* ubase = proj + (size_t)(b * SEQ + w * 256) * INC + g * 16;
    float xr = 0.f, xi = 0.f;
    __syncthreads();
    const u32x4 zero4 = (u32x4){0u, 0u, 0u, 0u};
    u32x4 un = *(const u32x4*)(ubase + (size_t)l15 * INC + 8 * lq);
    for (int tb = 0; tb < 16; ++tb) {
        const bf16x8 ua = __builtin_bit_cast(bf16x8, (lq < 2) ? un : zero4);
        { const int tn = tb < 15 ? tb + 1 : 15; un = *(const u32x4*)(ubase + (size_t)(tn * 16 + l15) * INC + 8 * lq); }
#pragma unroll
        for (int nt = 0; nt < 8; ++nt) { f32x4 d = __builtin_amdgcn_mfma_f32_16x16x32_bf16(ua, bfr[nt], (f32x4){0.f, 0.f, 0.f, 0.f}, 0, 0, 0);
#pragma unroll
            for (int r = 0; r < 4; ++r) bu[(4 * lq + r) * BP + 16 * nt + l15] = d[r]; }
        __syncthreads();
#pragma unroll
        for (int t = 0; t < 16; ++t) { const float br = bu[t * BP + ln], bi = bu[t * BP + 64 + ln]; const float nr = are * xr - aim * xi + br, ni = are * xi + aim * xr + bi; xr = nr; xi = ni; }
    }
    ends[(w * 64 + ln) * 2] = xr; ends[(w * 64 + ln) * 2 + 1] = xi;
    float pr = are, pi = aim;
#pragma unroll
    for (int i = 0; i < 8; ++i) { const float nr = pr * pr - pi * pi, ni = 2.0f * pr * pi; pr = nr; pi = ni; }
    __syncthreads();
    xr = 0.f; xi = 0.f;
    for (int ww = 0; ww < w; ++ww) { const float er = ends[(ww * 64 + ln) * 2], ei = ends[(ww * 64 + ln) * 2 + 1]; const float nr = pr * xr - pi * xi + er, ni = pr * xi + pi * xr + ei; xr = nr; xi = ni; }
    un = *(const u32x4*)(ubase + (size_t)l15 * INC + 8 * lq);
    for (int tb = 0; tb < 16; ++tb) {
        const bf16x8 ua = __builtin_bit_cast(bf16x8, (lq < 2) ? un : zero4);
        { const int tn = tb < 15 ? tb + 1 : 15; un = *(const u32x4*)(ubase + (size_t)(tn * 16 + l15) * INC + 8 * lq); }
        bf16_t uq[4];
#pragma unroll
        for (int r = 0; r < 4; ++r) uq[r] = proj[(size_t)(b * SEQ + w * 256 + tb * 16 + 4 * lq + r) * INC + g * 16 + l15];
#pragma unroll
        for (int nt = 0; nt < 8; ++nt) { f32x4 d = __builtin_amdgcn_mfma_f32_16x16x32_bf16(ua, bfr[nt], (f32x4){0.f, 0.f, 0.f, 0.f}, 0, 0, 0);
#pragma unroll
            for (int r = 0; r < 4; ++r) bu[(4 * lq + r) * BP + 16 * nt + l15] = d[r]; }
        __syncthreads();
#pragma unroll
        for (int t = 0; t < 16; ++t) { const float br = bu[t * BP + ln], bi = bu[t * BP + 64 + ln]; const float nr = are * xr - aim * xi + br, ni = are * xi + aim * xr + bi; xr = nr; xi = ni;
            xs[t * XP + ln] = f2bf(xr); xs[t * XP + 64 + ln] = f2bf(xi); }
        __syncthreads();
        f32x4 y = (f32x4){0.f, 0.f, 0.f, 0.f};
#pragma unroll
        for (int ks = 0; ks < 4; ++ks) { const bf16x8 xa = *(const LAS bf16x8*)(xs + l15 * XP + 32 * ks + 8 * lq); y = __builtin_amdgcn_mfma_f32_16x16x32_bf16(xa, cfr[ks], y, 0, 0, 0); }
#pragma unroll
        for (int r = 0; r < 4; ++r) { const size_t row = (size_t)(b * SEQ + w * 256 + tb * 16 + 4 * lq + r); const float uu = bf2f(uq[r]);
            yg[row * BW + g * 16 + l15] = f2bf(gelu_erf(y[r] + dsk * uu)); }
    }
}
__device__ __forceinline__ void mix_pool(const Ctx& F, const Params& p, int it) {
    const int b = it >> 5, t0 = (it & 31) * 64, ch = F.tid, win = 2 << (ch >> 7);
    const bf16_t* pp = (const bf16_t*)(p.ws + WS_PROJ) + (size_t)b * SEQ * INC + 4096;
    bf16_t* po = (bf16_t*)(p.ws + WS_POOLED) + (size_t)b * SEQ * BW + ch;
    LAS bf16_t* ps = (LAS bf16_t*)F.lds;
    for (int i = F.tid; i < 79 * 64; i += 512) { const int r = i >> 6, c8 = (i & 63) * 8, t = t0 - 15 + r;
        u32x4 v = (u32x4){0u, 0u, 0u, 0u};
        if (t >= 0) v = *(const u32x4*)(pp + (size_t)t * INC + c8);
        *(LAS u32x4*)(ps + r * 512 + c8) = v; }
    __syncthreads();
    float s = 0.f;
    for (int j = 0; j < win; ++j) s += bf2f(ps[(15 - j) * 512 + ch]);
    for (int tt = 0; tt < 64; ++tt) { const int t = t0 + tt;
        const float cur = bf2f(ps[(tt + 15) * 512 + ch]); const int cnt = (t + 1) < win ? (t + 1) : win;
        if (tt > 0) s += cur - bf2f(ps[(tt + 15 - win) * 512 + ch]);
        po[(size_t)t * BW] = f2bf(s * __builtin_amdgcn_rcpf((float)cnt) - cur); }
}
constexpr int MIX_HG = 64, MIX_SB = 1024, MIX_S5 = 512, MIX_POOL = 512;
__device__ __forceinline__ void phase_mixers_long(const Ctx& F, const Params& p, int l) {
    for (int it = blockIdx.x; it < MIX_HG; it += F.G) mix_hgrn2(F, p, l, it);
}
__device__ __forceinline__ void phase_mixers_short(const Ctx& F, const Params& p, int l) {
    for (;;) {
        int it = next_item(F, 1 + l);
        if (it >= MIX_SB + MIX_S5 + MIX_POOL) break;
        if (it < MIX_SB) mix_sb(F, p, it);
        else if ((it -= MIX_SB) < MIX_S5) mix_s5(F, p, l, it);
        else mix_pool(F, p, it - MIX_S5);
    }
}

__device__ __forceinline__ unsigned sort_key(float v, unsigned tag, unsigned mask) { const unsigned u = __float_as_uint(v); const unsigned s = u ^ ((u >> 31) ? 0xffffffffu : 0x80000000u); return (s & ~mask) | tag; }
__device__ __forceinline__ float key_val(unsigned k, unsigned mask) { const unsigned s = (k & ~mask) | (mask >> 1); const unsigned u = s ^ ((s >> 31) ? 0x80000000u : 0xffffffffu); return __uint_as_float(u); }
__device__ __forceinline__ void key_insert(unsigned (&val)[16], unsigned cv) {
#pragma unroll
    for (int j = 0; j < 16; ++j) { const unsigned hi = max(val[j], cv), lo = min(val[j], cv); val[j] = hi; cv = lo; }
}
__device__ __forceinline__ unsigned dppq_xor1(unsigned x) { return (unsigned)__builtin_amdgcn_update_dpp(0, (int)x, 0xB1, 0xf, 0xf, true); }
__device__ __forceinline__ unsigned dppq_xor2(unsigned x) { return (unsigned)__builtin_amdgcn_update_dpp(0, (int)x, 0x4E, 0xf, 0xf, true); }
#define KCE(a, b) do { const unsigned hi_ = max(a, b), lo_ = min(a, b); a = hi_; b = lo_; } while (0)
__device__ __forceinline__ void bitonic_merge16(unsigned (&v)[16]) {
#pragma unroll
    for (int j = 8; j >= 1; j >>= 1)
#pragma unroll
        for (int i = 0; i < 16; ++i) if ((i & j) == 0) KCE(v[i], v[i | j]);
}
__device__ __forceinline__ void bitonic_sort16(unsigned (&v)[16]) {
#pragma unroll
    for (int k = 2; k <= 16; k <<= 1)
#pragma unroll
        for (int j = k >> 1; j >= 1; j >>= 1)
#pragma unroll
            for (int i = 0; i < 16; ++i) if ((i & j) == 0) { if ((i & k) == 0 || k == 16) KCE(v[i], v[i | j]); else KCE(v[i | j], v[i]); }
}
__device__ __forceinline__ void top16_merge(unsigned (&a)[16], const unsigned (&b)[16]) {
#pragma unroll
    for (int i = 0; i < 16; ++i) a[i] = max(a[i], b[15 - i]);
    bitonic_merge16(a);
}
__device__ __forceinline__ void phase_topk(const Ctx& F, const Params& p) {
    const bf16_t* scores = (const bf16_t*)(p.ws + WS_G8);
    int* eidx = (int*)(p.ws + WS_EIDX); float* gate = (float*)(p.ws + WS_GATE);
    LAS bf16_t* sc = (LAS bf16_t*)F.lds;
    const int part = F.tid & 1, half = (F.tid >> 1) & 1, hd = (F.tid >> 2) & 7, tl = F.tid >> 5;
    for (int it8 = blockIdx.x * 8; it8 < M / 16; it8 += F.G * 8)
#pragma unroll 1
    for (int it4 = it8; it4 < it8 + 8; it4 += 4) {
      unsigned s0[16], s1[16];
#pragma unroll
      for (int j = 0; j < 16; ++j) { s0[j] = 0u; s1[j] = 0u; }
#pragma unroll 1
      for (int sub = 0; sub < 4; ++sub) { const int it = it4 + sub;
        __syncthreads();
        { const u32x4* src = (const u32x4*)(scores + (size_t)it * 16 * D); LAS u32x4* dst = (LAS u32x4*)sc;
#pragma unroll
          for (int i = 0; i < 8; ++i) dst[i * 512 + F.tid] = __builtin_nontemporal_load(src + i * 512 + F.tid); }
        __syncthreads();
        unsigned k0[16];
        const LAS bf16_t* row = sc + tl * D + hd * 256 + half * 128 + part * 64;
        {
            unsigned ga[16], gb[16];
#pragma unroll
            for (int i = 0; i < 16; ++i) { const int idx = (i + F.tid) & 63; k0[i] = sort_key(bf2f(row[idx]), 127u - (unsigned)(part * 64 + idx), 127u); }
#pragma unroll
            for (int i = 0; i < 16; ++i) { const int idx = (16 + i + F.tid) & 63; ga[i] = sort_key(bf2f(row[idx]), 127u - (unsigned)(part * 64 + idx), 127u); }
            bitonic_sort16(k0); bitonic_sort16(ga); top16_merge(k0, ga);
#pragma unroll
            for (int i = 0; i < 16; ++i) { const int idx = (32 + i + F.tid) & 63; ga[i] = sort_key(bf2f(row[idx]), 127u - (unsigned)(part * 64 + idx), 127u); }
#pragma unroll
            for (int i = 0; i < 16; ++i) { const int idx = (48 + i + F.tid) & 63; gb[i] = sort_key(bf2f(row[idx]), 127u - (unsigned)(part * 64 + idx), 127u); }
            bitonic_sort16(ga); bitonic_sort16(gb); top16_merge(ga, gb); top16_merge(k0, ga);
        }
        { unsigned o[16];
#pragma unroll
          for (int j = 0; j < 16; ++j) o[j] = dppq_xor1(k0[j]);
          top16_merge(k0, o); }
        { const bool mine = (F.tid & 3) == sub;
#pragma unroll
          for (int j = 0; j < 16; ++j) { const unsigned k1 = dppq_xor2(k0[j]); const unsigned h0 = half ? k1 : k0[j], h1 = half ? k0[j] : k1;
              s0[j] = mine ? h0 : s0[j]; s1[j] = mine ? h1 : s1[j]; } }
      }
        __syncthreads();
        {   const int it = it4 + (F.tid & 3);
            LAS unsigned* kl = (LAS unsigned*)F.lds + F.tid * 33;
            float v0[16], v1[16];
#pragma unroll
            for (int j = 0; j < 16; ++j) { v0[j] = key_val(s0[j], 127u); v1[j] = key_val(s1[j], 127u); kl[j] = 127u - (s0[j] & 127u); kl[16 + j] = 127u - (s1[j] & 127u); }
            unsigned bk[16], ga[16], gb[16];
            {   int n = 0;
#pragma unroll
                for (int i = 0; i < 16; ++i)
#pragma unroll
                    for (int j = 0; j < 16; ++j) if ((i + 1) * (j + 1) <= 16) { const unsigned kv = sort_key(v0[i] + v1[j], 255u - (unsigned)(i * 16 + j), 255u);
                        if (n < 16) bk[n] = kv; else if (n < 32) ga[n - 16] = kv; else if (n < 48) gb[n - 32] = kv; ++n; }
            }
            bitonic_sort16(bk); bitonic_sort16(ga); top16_merge(bk, ga);
            {
                int n = 0;
#pragma unroll
                for (int q = 0; q < 16; ++q) ga[q] = 0u;
#pragma unroll
                for (int i = 0; i < 16; ++i)
#pragma unroll
                    for (int j = 0; j < 16; ++j) if ((i + 1) * (j + 1) <= 16) { if (n >= 48) ga[n - 48] = sort_key(v0[i] + v1[j], 255u - (unsigned)(i * 16 + j), 255u); ++n; }
            }
            bitonic_sort16(gb); bitonic_sort16(ga); top16_merge(gb, ga); top16_merge(bk, gb);
            float ex[16], sum = 0.f; const float top = key_val(bk[0], 255u);
#pragma unroll
            for (int j = 0; j < 16; ++j) { ex[j] = __expf(key_val(bk[j], 255u) - top); sum += ex[j]; }
            const float inv = 1.0f / sum;
            int bi[16];
#pragma unroll
            for (int j = 0; j < 16; ++j) { const unsigned pr = 255u - (bk[j] & 255u); bi[j] = (int)(kl[pr >> 4] * 128u + kl[16 + (pr & 15u)]); }
            const int t = it * 16 + tl;
            int* ep = eidx + (size_t)t * 128 + hd * 16; float* gp = gate + (size_t)t * 128 + hd * 16;
#pragma unroll
            for (int j = 0; j < 16; j += 4) { *(int4*)(ep + j) = make_int4(bi[j], bi[j + 1], bi[j + 2], bi[j + 3]); *(f32x4*)(gp + j) = (f32x4){ex[j] * inv, ex[j + 1] * inv, ex[j + 2] * inv, ex[j + 3] * inv}; }
        }
    }
}
__device__ __forceinline__ float dot16_fp8(const f32x2 (&h2)[8], const u32x4 r) {
    f32x2 z = (f32x2){0.f, 0.f};
#pragma unroll
    for (int w = 0; w < 4; ++w) { const f32x2 lo = __builtin_amdgcn_cvt_pk_f32_fp8((int)r[w], false), hi = __builtin_amdgcn_cvt_pk_f32_fp8((int)r[w], true);
        z = __builtin_elementwise_fma(h2[2 * w], lo, z); z = __builtin_elementwise_fma(h2[2 * w + 1], hi, z); }
    return z[0] + z[1];
}
#define PEER_GATHER(dst, esrc) do { _Pragma("unroll") for (int ii = 0; ii < 8; ++ii) { const int e_ = __shfl((esrc), 8 * ii + g); dst[ii] = *(const u32x4*)(T8 + (unsigned)(e_ * 128 + j * 16)); } } while (0)
__device__ __forceinline__ void peer_v_accum(const u32x4 (&r)[8], float wsrc, f32x2 (&ac2)[8], int g) {
#pragma unroll
    for (int ii = 0; ii < 8; ++ii) { const float wv = __shfl(wsrc, 8 * ii + g); const f32x2 ws2 = (f32x2){wv, wv};
#pragma unroll
        for (int w = 0; w < 4; ++w) { const f32x2 lo = __builtin_amdgcn_cvt_pk_f32_fp8((int)r[ii][w], false), hi = __builtin_amdgcn_cvt_pk_f32_fp8((int)r[ii][w], true);
            ac2[2 * w] = __builtin_elementwise_fma(ws2, lo, ac2[2 * w]); ac2[2 * w + 1] = __builtin_elementwise_fma(ws2, hi, ac2[2 * w + 1]); } }
}
__device__ __forceinline__ void peer_u_accum_lds(const u32x4 (&r)[8], const f32x2 (&h)[8], LAS float* zrow, int half, int g, int j, bool b0, bool b1, bool b2) {
    float pz[8];
#pragma unroll
    for (int ii = 0; ii < 8; ++ii) pz[ii] = dot16_fp8(h, r[ii]);
    float q4[4], q2[2];
#pragma unroll
    for (int i = 0; i < 4; ++i) { const float snd = b2 ? pz[i] : pz[i + 4]; const float rcv = __shfl_xor(snd, 4); q4[i] = (b2 ? pz[i + 4] : pz[i]) + rcv; }
#pragma unroll
    for (int i = 0; i < 2; ++i) { const float snd = b1 ? q4[i] : q4[i + 2]; const float rcv = __shfl_xor(snd, 2); q2[i] = (b1 ? q4[i + 2] : q4[i]) + rcv; }
    const float snd = b0 ? q2[0] : q2[1]; const float rcv = __shfl_xor(snd, 1); const float q1 = (b0 ? q2[1] : q2[0]) + rcv;
    zrow[8 * (half * 8 + j) + g] += q1;
}
__device__ __forceinline__ void phase_peer_fused(const Ctx& F, const Params& p, int l, float* xres) {
    const bf16_t* H = (const bf16_t*)(p.ws + WS_H);
    const int* eidx = (const int*)(p.ws + WS_EIDX); const float* gate = (const float*)(p.ws + WS_GATE);
    const float* su = (const float*)(p.ws + WS_SU) + l * NEXP; const float* sv = (const float*)(p.ws + WS_SV) + l * NEXP;
    const float* g2 = (const float*)(p.ws + WS_MOD) + (size_t)l * BATCH * ADA + 5 * D;
    const int g = F.lane >> 3, j = F.lane & 7; const bool b0 = F.lane & 1, b1 = F.lane & 2, b2 = F.lane & 4, b3 = F.lane & 8, b4 = F.lane & 16, b5 = F.lane & 32;
    LAS float* zl = (LAS float*)F.lds + F.wid * (16 * 128);
    for (int tile = blockIdx.x; tile < M / 128; tile += F.G) {
        const int t0 = tile * 128 + F.wid * 16, b = t0 / SEQ;
#pragma unroll
        for (int i = 0; i < 32; ++i) zl[i * 64 + F.lane] = 0.f;
        {   const unsigned char* T8b = p.ws + WS_PU8 + (size_t)l * 16 * NEXP * 128;
            const unsigned jo = (unsigned)(j * 16), lo_ = (unsigned)F.lane;
            u32x4 hw0 = *(const u32x4*)(H + (size_t)t0 * D + jo), hw1 = *(const u32x4*)(H + (size_t)t0 * D + 8 + jo); int e_a = (eidx + (size_t)t0 * 128)[lo_], e_b = (eidx + (size_t)t0 * 128 + 64)[lo_];
            u32x4 ra[8], rb[8];
            { const unsigned char* T8 = T8b; PEER_GATHER(ra, e_a); }
#pragma unroll 1
            for (int st = 0; st < 256; ++st) {
                const int s = st >> 4, tk = st & 15, sx = st < 255 ? st + 1 : st, sn = sx >> 4, tn = sx & 15;
                const bf16_t* hn = H + ((size_t)(t0 + tn) * D + sn * 128);
                const u32x4 nw0 = __builtin_nontemporal_load((const u32x4*)(hn + jo)), nw1 = __builtin_nontemporal_load((const u32x4*)(hn + 8 + jo)); const int* en = eidx + (size_t)(t0 + tn) * 128; const int ne_a = en[lo_], ne_b = (en + 64)[lo_];
                { const unsigned char* T8 = T8b + (size_t)s * NEXP * 128; PEER_GATHER(rb, e_b); }
                f32x2 h[8];
#pragma unroll
                for (int q = 0; q < 4; ++q) { h[q] = (f32x2){bflo(hw0[q]), bfhi(hw0[q])}; h[4 + q] = (f32x2){bflo(hw1[q]), bfhi(hw1[q])}; }
                peer_u_accum_lds(ra, h, zl + tk * 128, 0, g, j, b0, b1, b2);
                { const unsigned char* T8 = T8b + (size_t)sn * NEXP * 128; PEER_GATHER(ra, ne_a); }
                peer_u_accum_lds(rb, h, zl + tk * 128, 1, g, j, b0, b1, b2);
                hw0 = nw0; hw1 = nw1; e_a = ne_a; e_b = ne_b;
            }
        }
        __syncthreads();
#pragma unroll 4
        for (int tk = 0; tk < 16; ++tk) { const float rs = rsqrtf((float)((const unsigned long long*)(p.ws + WS_RSS))[t0 + tk] * (RSS_INV / D) + EPS);
#pragma unroll
            for (int hh = 0; hh < 2; ++hh) { const int k = hh * 64 + F.lane; const size_t gi = (size_t)(t0 + tk) * 128 + k; const int e = eidx[gi];
                zl[tk * 128 + k] = gate[gi] * gelu_erf((zl[tk * 128 + k] * rs + ((const float*)(p.ws + WS_SD))[(size_t)b * NEXP + e]) * su[e]) * sv[e]; } }
        __syncthreads();
        {   const unsigned char* T8b = p.ws + WS_PV8 + (size_t)l * 16 * NEXP * 128;
            const unsigned colj = (unsigned)(j * 16 + (b3 ? 8 : 0) + (b4 ? 4 : 0) + (b5 ? 2 : 0)), lo_ = (unsigned)F.lane;
            int e_a = (eidx + (size_t)t0 * 128)[lo_], e_b = (eidx + (size_t)t0 * 128 + 64)[lo_];
            u32x4 ra[8], rb[8];
            { const unsigned char* T8 = T8b; PEER_GATHER(ra, e_a); }
#pragma unroll 1
            for (int st = 0; st < 256; ++st) {
                const int s = st >> 4, tk = st & 15, sx = st < 255 ? st + 1 : st, sn = sx >> 4, tn = sx & 15;
                const int* en = eidx + (size_t)(t0 + tn) * 128; const int ne_a = en[lo_], ne_b = (en + 64)[lo_];
                const float w_a = zl[tk * 128 + F.lane], w_b = zl[tk * 128 + 64 + F.lane];
                const f32x2 gv = *(const f32x2*)(g2 + ((size_t)b * ADA + s * 128) + colj);
                float* xp = xres + ((size_t)(t0 + tk) * D + s * 128) + colj; const f32x2 xv = __builtin_nontemporal_load((const f32x2*)xp);
                { const unsigned char* T8 = T8b + (size_t)s * NEXP * 128; PEER_GATHER(rb, e_b); }
                f32x2 ac2[8];
#pragma unroll
                for (int c = 0; c < 8; ++c) ac2[c] = (f32x2){0.f, 0.f};
                peer_v_accum(ra, w_a, ac2, g);
                { const unsigned char* T8 = T8b + (size_t)sn * NEXP * 128; PEER_GATHER(ra, ne_a); }
                peer_v_accum(rb, w_b, ac2, g);
                float acc[16];
#pragma unroll
                for (int c = 0; c < 8; ++c) { acc[2 * c] = ac2[c][0]; acc[2 * c + 1] = ac2[c][1]; }
                float a8[8], a4[4], a2[2];
#pragma unroll
                for (int i = 0; i < 8; ++i) { const float snd = b3 ? acc[i] : acc[i + 8]; const float rcv = __shfl_xor(snd, 8); a8[i] = (b3 ? acc[i + 8] : acc[i]) + rcv; }
#pragma unroll
                for (int i = 0; i < 4; ++i) { const float snd = b4 ? a8[i] : a8[i + 4]; const float rcv = __shfl_xor(snd, 16); a4[i] = (b4 ? a8[i + 4] : a8[i]) + rcv; }
#pragma unroll
                for (int i = 0; i < 2; ++i) { const float snd = b5 ? a4[i] : a4[i + 2]; const float rcv = __shfl_xor(snd, 32); a2[i] = (b5 ? a4[i + 2] : a4[i]) + rcv; }
                __builtin_nontemporal_store((f32x2){xv[0] + gv[0] * a2[0], xv[1] + gv[1] * a2[1]}, (f32x2*)xp);
                e_a = ne_a; e_b = ne_b;
            }
        }
        asm volatile("s_waitcnt vmcnt(0)" ::: "memory");
        __builtin_amdgcn_fence(__ATOMIC_ACQUIRE, "agent");
        asm volatile("s_waitcnt vmcnt(0)" ::: "memory");
        if (l + 1 < DEPTH) { const float* mod1 = (const float*)(p.ws + WS_MOD) + (size_t)(l + 1) * BATCH * ADA; const float* gn = p.nmg + (l + 1) * D;
            asm volatile("" : "+s"(mod1), "+s"(gn));
#pragma unroll 1
            for (int tk = 0; tk < 16; tk += 4) norm_rows<0, 4>(F, t0 + tk, xres, gn, mod1, mod1 + D, (bf16_t*)(p.ws + WS_H), nullptr);
        } else { const float* gn = p.final_gain;
            asm volatile("" : "+s"(gn));
#pragma unroll 1
            for (int tk = 0; tk < 16; tk += 4) norm_rows<1, 4>(F, t0 + tk, xres, gn, nullptr, nullptr, nullptr, xres);
        }
    }
}
constexpr int PH_PER_LAYER = 11, N_PHASES = 1 + DEPTH * PH_PER_LAYER;
typedef const __attribute__((address_space(4))) Params* KParamPtr;
#if defined(__HIP_DEVICE_COMPILE__)
#define PARAMS() ({ KParamPtr k_ = (KParamPtr)__builtin_amdgcn_kernarg_segment_ptr(); asm volatile("" : "+s"(k_)); *k_; })
#else
#define PARAMS() (Params{})
#endif
#define MAKE_CTX(Fn) Ctx Fn; { Fn.lds = (LAS unsigned char*)lds_raw; Fn.misc = (volatile LAS unsigned*)(Fn.lds + MISC_OFF); int t_ = threadIdx.x; asm volatile("" : "+v"(t_)); Fn.tid = t_; Fn.lane = t_ & 63; Fn.wid = __builtin_amdgcn_readfirstlane(t_ >> 6); Fn.G = gridDim.x; Fn.ctl = (unsigned*)(p.ws + WS_CTL); }
#define PHASE_ENV const Params p = PARAMS(); unsigned char* ws = p.ws; bf16_t* Hb = (bf16_t*)(ws + WS_H); bf16_t* PROJ = (bf16_t*)(ws + WS_PROJ); unsigned char* G8 = ws + WS_G8; const float* mod = (const float*)(ws + WS_MOD) + (size_t)l_ * BATCH * ADA; const float* xin = (l_ == 0) ? p.x : p.out; MAKE_CTX(F); (void)Hb; (void)PROJ; (void)G8; (void)mod; (void)xin; (void)F
#define IN(k) (lo <= (k) && (k) < hi)
#define SEAM(k) do { if (IN((k) + 1)) { const Params pq = PARAMS(); XcdBarrier bar; bar.bar = (unsigned*)(pq.ws + WS_CTL); bar.x = xb_xcc_id(); bar.st = (volatile LAS unsigned*)((LAS unsigned char*)lds_raw + MISC_OFF); xcd_barrier(bar); } } while (0)
template <int l>
__device__ __forceinline__ void layer_phases(const int lo, const int hi) {
    extern __shared__ __attribute__((aligned(16))) unsigned char lds_raw[];
        const int pb = 1 + l * PH_PER_LAYER;
        const int l_ = l;
        if (l == 0 && IN(pb + 0)) { PHASE_ENV; const Ctx& Fp = F; phase_norm<0>(Fp, xin, p.nmg + l * D, mod, mod + D, Hb, nullptr); SEAM(pb + 0); }
        if (IN(pb + 1)) { PHASE_ENV; pg8::Gemm g{Hb, (const bf16_t*)(ws + WS_BCAT) + (size_t)l * NCAT * D, M, INC, D, D, D, 0, 0, 0}; pg8::StaticOrder S; S.init(M, INC, F.G, (int)blockIdx.x);
            EpiBf16 E{PROJ, INC, 0}; pg8::gemm_phase(F.lds, g, S, E); SEAM(pb + 1); }
        if (IN(pb + 2)) { PHASE_ENV; const Ctx& Fp = F; phase_mixers_long(Fp, p, l);
            __syncthreads();
            { pg8::Gemm g{Hb, (const bf16_t*)(ws + WS_BCAT) + ((size_t)l * NCAT + INC) * D, M, 4 * D, D, D, D, 0, 0, 0};
              pg8::LateOrder S; S.init(M, 4 * D, F.G, (int)blockIdx.x); if (F.G == 256) { S.nhg = 64; S.r0 = 13; S.ex = 4; } else { S.nhg = 0; S.r0 = (S.nwg + F.G - 1) / F.G; S.ex = 0; }
              EpiGateT E{G8}; pg8::gemm_phase(F.lds, g, S, E); }
            __syncthreads();
            phase_mixers_short(Fp, p, l);
            SEAM(pb + 2); }
        if (IN(pb + 3)) { PHASE_ENV;
            { pg8::Gemm g{(const bf16_t*)(ws + WS_YG), (const bf16_t*)(ws + WS_WGLUT) + (size_t)l * BW * BW, M, BW, BW, BW, BW, 0, 0, 0}; pg8::StaticOrder S; S.init(M, BW, F.G, (int)blockIdx.x);
              EpiGlu E{(const bf16_t*)(ws + WS_YG), p.b_glu + l * BW, (bf16_t*)(ws + WS_YCAT)}; pg8::gemm_phase(F.lds, g, S, E); }
            { pg8::Gemm g{(const bf16_t*)(ws + WS_POOLED), (const bf16_t*)(ws + WS_POOLT) + (size_t)l * BW * BW, M, BW, BW, BW, BW, 0, 0, 0}; pg8::StaticOrder S; S.init(M, BW, F.G, (int)blockIdx.x);
              EpiBf16 E{(bf16_t*)(ws + WS_YCAT), D, 1536}; pg8::gemm_phase(F.lds, g, S, E); }
            { const Ctx& Fp = F; aux_shift_tables(Fp, p, l); }
            SEAM(pb + 3); }
        if (IN(pb + 4)) { PHASE_ENV;
            { pg8::Gemm g{(const bf16_t*)(ws + WS_YCAT), (const bf16_t*)(ws + WS_WBT) + (size_t)l * D * D, M, D, D, D, D, 0, 0, 0}; pg8::StaticOrder S; S.init(M, D, F.G, (int)blockIdx.x); EpiMerge E{G8, PROJ}; pg8::gemm_phase(F.lds, g, S, E); }
            SEAM(pb + 4); }
        if (IN(pb + 5)) { PHASE_ENV; pg8::Gemm g{PROJ, (const bf16_t*)(ws + WS_WOT) + (size_t)l * D * D, M, D, D, D, D, 0, 0, 0}; pg8::StaticOrder S; S.init(M, D, F.G, (int)blockIdx.x);
            EpiResidN E{xin, mod + 2 * D, p.out, p.nfg + l * D, mod + 4 * D, Hb, (unsigned long long*)(ws + WS_RSS)}; pg8::gemm_phase(F.lds, g, S, E); SEAM(pb + 6); }
        if (IN(pb + 7)) { PHASE_ENV; pg8::Gemm g{Hb, (const bf16_t*)(ws + WS_WQT) + (size_t)l * D * D, M, D, D, D, D, 0, 0, 0}; pg8::StaticOrder S; S.init(M, D, F.G, (int)blockIdx.x);
            EpiScore E{(bf16_t*)(ws + WS_G8), (const unsigned long long*)(ws + WS_RSS), (const float*)(ws + WS_C0)}; pg8::gemm_phase(F.lds, g, S, E); SEAM(pb + 8); }
        if (IN(pb + 9)) { PHASE_ENV; const Ctx& Fp = F; phase_topk(Fp, p);
            asm volatile("s_waitcnt vmcnt(0)" ::: "memory"); __syncthreads(); __builtin_amdgcn_fence(__ATOMIC_ACQUIRE, "agent"); }
        if (IN(pb + 10)) { PHASE_ENV; const Ctx& Fp = F; phase_peer_fused(Fp, p, l, p.out); SEAM(pb + 10); }
    }
__global__ void __launch_bounds__(512, 2) mega(Params p_unused) {
    extern __shared__ __attribute__((aligned(16))) unsigned char lds_raw[];
    {   volatile LAS unsigned* misc0 = (volatile LAS unsigned*)((LAS unsigned char*)lds_raw + MISC_OFF);
        if (threadIdx.x < 16) misc0[threadIdx.x] = 0u;
        __syncthreads();
        if (N_LAUNCHES == 1) { const Params p0 = PARAMS(); (void)xcd_barrier_post((unsigned*)(p0.ws + WS_CTL), misc0); } }
    int lo, hi; { const Params p0 = PARAMS(); lo = p0.ph_lo; hi = p0.ph_hi; }
    { const int l_ = 0; if (IN(0)) { PHASE_ENV; const Ctx& Fp = F; phase_prologue(Fp, p); SEAM(0); } }
    layer_phases<0>(lo, hi);
    layer_phases<1>(lo, hi);
#undef IN
#undef SEAM
#undef PHASE_ENV
}

extern "C" void kernel_launch(void* const* d_in, const int* in_sizes, int n_in, void* d_out, int out_size, void* d_ws, size_t ws_size, hipStream_t stream) {
    static int grid = 0;
    if (grid == 0) {
        if (n_in != 29 || ws_size < WS_END) { fprintf(stderr, "kernel_launch: need 29 inputs and %zu bytes of workspace; got %d, %zu\n", (size_t)WS_END, n_in, ws_size); grid = -1; return; }
        int dev = 0, cus = 0, per_cu = 0;
        if (hipGetDevice(&dev) != hipSuccess || hipDeviceGetAttribute(&cus, hipDeviceAttributeMultiprocessorCount, dev) != hipSuccess) { grid = -1; return; }
        if (hipFuncSetAttribute((const void*)mega, hipFuncAttributeMaxDynamicSharedMemorySize, LDS_BYTES) != hipSuccess) { fprintf(stderr, "kernel_launch: hipFuncSetAttribute failed\n"); grid = -1; return; }
        if (hipOccupancyMaxActiveBlocksPerMultiprocessor(&per_cu, (const void*)mega, 512, LDS_BYTES) != hipSuccess || per_cu < 1) { fprintf(stderr, "kernel_launch: occupancy query says %d\n", per_cu); }
        (void)hipGetLastError();
        grid = cus;
    }
    if (grid < 0) return;
    (void)hipMemsetAsync((char*)d_ws + WS_CTL, 0, CTL_BYTES, stream);
    Params p{};
    const float** pp = (const float**)&p;
    for (int i = 0; i < 29; ++i) pp[i] = (const float*)d_in[i];
    p.out = (float*)d_out; p.ws = (unsigned char*)d_ws;
#if N_LAUNCHES == 1
    p.ph_lo = 0; p.ph_hi = N_PHASES;
    hipLaunchKernelGGL(mega, dim3(grid), dim3(512), LDS_BYTES, stream, p);
#else
    for (int k = 0; k < N_PHASES; ++k) { p.ph_lo = k; p.ph_hi = k + 1; hipLaunchKernelGGL(mega, dim3(grid), dim3(512), LDS_BYTES, stream, p); }
#endif
}
```
